# Optimizing an MI355X kernel written in HIP

```python
import math
import jax
import jax.numpy as jnp
from jax import lax
import numpy as np

D_MODEL = 1024
BATCH = 8
SEQ = 4096
DEPTH = 4

HEAD_DIM = 64
D_MIX = D_MODEL
H_RWKV = D_MIX // (4 * HEAD_DIM)
C_RWKV = H_RWKV * HEAD_DIM
H_FOX = (D_MIX - C_RWKV) // (2 * HEAD_DIM)
C_FOX = H_FOX * HEAD_DIM
H_NSA = (D_MIX - C_RWKV - C_FOX) // HEAD_DIM
C_NSA = H_NSA * HEAD_DIM
G_NSA = 2
HPG = H_NSA // G_NSA
C_KV_NSA = G_NSA * HEAD_DIM
R_DECAY = 32
R_AAA = 32
R_GATE = 64
L_CMP = 32
D_CMP = 16
CMP_HID = 128
L_SLC = 64
N_SLC = 16
N_LOCAL = 2
WINDOW = 512
Q_BLOCK = 128
SLC_Q_CHUNK = 64
NUM_BUCKETS = 32
MAX_DISTANCE = 128
D_FF = 2816
CONV_W = 3
RMS_EPS = 1e-6
GN_EPS = 64e-5
NEG_INF = -1e30
FORCE_SCORE = 1e4

RWKV_COLS = (C_RWKV, C_RWKV, C_RWKV, R_DECAY, R_AAA, R_GATE)
FOX_COLS = (C_FOX, C_FOX, C_FOX, H_FOX)
NSA_COLS = (C_NSA,) + (C_KV_NSA,) * 6 + (3 * H_NSA,)
N_RWKV_IN = sum(RWKV_COLS)
N_FOX_IN = sum(FOX_COLS)
N_NSA_IN = sum(NSA_COLS)
N_IN = N_RWKV_IN + N_FOX_IN + N_NSA_IN

kernel_name = "hybrid_rwkv7_fox_nsa_convffn"


def rmsnorm(x, g):
    xf = x.astype(jnp.float32)
    y = xf * lax.rsqrt(jnp.mean(xf * xf, axis=-1, keepdims=True) + RMS_EPS)
    return (y * g.astype(jnp.float32)).astype(x.dtype)


def split_cols(p, sizes):
    idx = np.cumsum(np.array(sizes))[:-1].tolist()
    return jnp.split(p, idx, axis=-1)


def shift_right(x):
    return jnp.pad(x, ((0, 0), (1, 0), (0, 0)))[:, : x.shape[1]]


def masked_softmax(logits, mask):
    p = jax.nn.softmax(jnp.where(mask, logits, NEG_INF), axis=-1)
    return jnp.where(mask, p, 0.0)


def t5_bucket(dist):
    n = jnp.maximum(dist, 0)
    max_exact = NUM_BUCKETS // 2
    nf = jnp.maximum(n, 1).astype(jnp.float32)
    large = max_exact + (jnp.log(nf / max_exact) / math.log(MAX_DISTANCE / max_exact)
                         * (NUM_BUCKETS - max_exact)).astype(jnp.int32)
    large = jnp.minimum(large, NUM_BUCKETS - 1)
    return jnp.where(n < max_exact, n, large)


def wkv7_scan(r, w, k, v, a, b):
    B, S, H, N = r.shape

    def step(state, inp):
        r_t, w_t, k_t, v_t, a_t, b_t = inp
        sa = jnp.einsum('bhvk,bhk->bhv', state, a_t)
        state = (state * w_t[:, :, None, :] + sa[..., None] * b_t[:, :, None, :]
                 + v_t[..., None] * k_t[:, :, None, :])
        return state, jnp.einsum('bhvk,bhk->bhv', state, r_t)

    xs = tuple(jnp.moveaxis(t, 1, 0) for t in (r, w, k, v, a, b))
    state0 = jnp.zeros((B, H, N, N), jnp.float32)
    _, ys = lax.scan(step, state0, xs)
    return jnp.moveaxis(ys, 0, 1)


def rwkv7_mix(p, mu, w0, w_up, a0, a_up, g_up, k_k, k_a, r_k, ln_w, ln_b):
    B, S, _ = p.shape
    dt = p.dtype
    p = p + (shift_right(p) - p) * mu
    r, k, v, xw, xa, xg = split_cols(p.astype(jnp.float32), RWKV_COLS)
    w = -jax.nn.softplus(-(w0 + jnp.tanh(xw) @ w_up)) - 0.5
    decay = jnp.exp(-jnp.exp(w))
    a = jax.nn.sigmoid(a0 + xa @ a_up)
    g = jax.nn.sigmoid(xg) @ g_up
    heads = lambda t: t.reshape(B, S, H_RWKV, HEAD_DIM)
    kk = heads(k * k_k)
    kk = kk / jnp.maximum(jnp.linalg.norm(kk, axis=-1, keepdims=True), 1e-12)
    k = k * (1.0 + (a - 1.0) * k_a)
    r_h, k_h, v_h, a_h = heads(r), heads(k), heads(v), heads(a)
    y = wkv7_scan(r_h, heads(decay), k_h, v_h, -kk, kk * a_h)
    mean = jnp.mean(y, axis=-1, keepdims=True)
    var = jnp.mean(jnp.square(y - mean), axis=-1, keepdims=True)
    yn = ((y - mean) * lax.rsqrt(var + GN_EPS)).reshape(B, S, C_RWKV) * ln_w + ln_b
    bonus = jnp.sum(r_h * k_h * r_k, axis=-1, keepdims=True) * v_h
    return ((yn + bonus.reshape(B, S, C_RWKV)) * g).astype(dt)


def fox_mix(p, b_f):
    B, S, _ = p.shape
    q, k, v, f_logit = split_cols(p, FOX_COLS)
    to_heads = lambda t: t.reshape(B, S, H_FOX, HEAD_DIM).transpose(0, 2, 1, 3)
    q, k, v = to_heads(q), to_heads(k), to_heads(v)
    log_f = jax.nn.log_sigmoid((f_logit + b_f).astype(jnp.float32))
    cum = jnp.cumsum(log_f, axis=1).transpose(0, 2, 1)
    scale = HEAD_DIM ** -0.5
    kpos = jnp.arange(S)

    def block(i):
        q0 = i * Q_BLOCK
        qb = lax.dynamic_slice_in_dim(q, q0, Q_BLOCK, axis=2)
        cb = lax.dynamic_slice_in_dim(cum, q0, Q_BLOCK, axis=2)
        logits = (jnp.einsum('bhqd,bhkd->bhqk', qb, k).astype(jnp.float32) * scale
                  + cb[..., None] - cum[:, :, None, :])
        qpos = q0 + jnp.arange(Q_BLOCK)
        probs = masked_softmax(logits, kpos[None, :] <= qpos[:, None])
        return jnp.einsum('bhqk,bhkd->bhqd', probs.astype(v.dtype), v)

    out = lax.map(block, jnp.arange(S // Q_BLOCK))
    return out.transpose(1, 0, 3, 2, 4).reshape(B, S, C_FOX)


def nsa_mix(p, pe_k, pe_v, ck_w1, ck_w2, cv_w1, cv_w2, rel_bias):
    B, S, _ = p.shape
    dt = p.dtype
    q, kc, vc, ks, vs, kw, vw, gate_logit = split_cols(p, NSA_COLS)
    q = q.reshape(B, S, G_NSA, HPG, HEAD_DIM)
    kvh = lambda t: t.reshape(B, S, G_NSA, HEAD_DIM)
    kc, vc, ks, vs, kw, vw = (kvh(t) for t in (kc, vc, ks, vs, kw, vw))
    scale = HEAD_DIM ** -0.5
    tpos = jnp.arange(S)

    n_ch = S // D_CMP
    ov = L_CMP // D_CMP
    n_cmp = n_ch - ov + 1

    def compress(t, pe, w1, w2):
        ch = t.reshape(B, n_ch, D_CMP, G_NSA, HEAD_DIM)
        blocks = jnp.concatenate([ch[:, j:j + n_cmp] for j in range(ov)], axis=2)
        blocks = blocks + pe[:, None, :]
        flat = blocks.transpose(0, 1, 3, 2, 4).reshape(B, n_cmp, G_NSA, L_CMP * HEAD_DIM)
        return jax.nn.gelu(flat @ w1) @ w2

    k_cmp = compress(kc, pe_k, ck_w1, ck_w2)
    v_cmp = compress(vc, pe_v, cv_w1, cv_w2)
    cmp_start = jnp.arange(n_cmp) * D_CMP
    cmp_end = cmp_start + L_CMP - 1
    dist_c = tpos[:, None] - cmp_end[None, :]
    bias_c = rel_bias[t5_bucket(dist_c)].reshape(S, n_cmp, G_NSA, HPG).transpose(2, 3, 0, 1)
    logits_c = jnp.einsum('bsghd,bcgd->bghsc', q, k_cmp).astype(jnp.float32) * scale + bias_c
    p_cmp = masked_softmax(logits_c, dist_c >= 0)
    o_cmp = jnp.einsum('bghsc,bcgd->bsghd', p_cmp.astype(dt), v_cmp)

    nsb = S // L_SLC
    slc_start = jnp.arange(nsb) * L_SLC
    overlap = ((cmp_start[:, None] <= slc_start[None, :] + L_SLC - 1)
               & (cmp_end[:, None] >= slc_start[None, :])).astype(jnp.float32)
    imp = jnp.einsum('bghsc,cj->bgsj', p_cmp, overlap)
    cur = tpos // L_SLC
    jb = jnp.arange(nsb)
    back = cur[:, None] - jb[None, :]
    valid = back >= 0
    forced = (jb[None, :] == 0) | (valid & (back < N_LOCAL))
    score = jnp.where(valid, jnp.where(forced, FORCE_SCORE, imp), -1.0)
    n_sel = min(N_SLC, nsb)
    top_val, top_idx = lax.top_k(score, n_sel)
    sel_ok = top_val >= 0.0

    kb = ks.reshape(B, nsb, L_SLC, G_NSA, HEAD_DIM).transpose(0, 3, 1, 2, 4)
    vb = vs.reshape(B, nsb, L_SLC, G_NSA, HEAD_DIM).transpose(0, 3, 1, 2, 4)
    gather = jax.vmap(jax.vmap(lambda blocks, idx: blocks[idx]))
    qg = q.transpose(0, 2, 1, 3, 4)
    tbl_g = rel_bias.reshape(NUM_BUCKETS, G_NSA, HPG).transpose(1, 0, 2)
    g_idx = jnp.arange(G_NSA)[None, :, None, None, None]

    def slc_chunk(i):
        q0 = i * SLC_Q_CHUNK
        qc = lax.dynamic_slice_in_dim(qg, q0, SLC_Q_CHUNK, axis=2)
        ic = lax.dynamic_slice_in_dim(top_idx, q0, SLC_Q_CHUNK, axis=2)
        okc = lax.dynamic_slice_in_dim(sel_ok, q0, SLC_Q_CHUNK, axis=2)
        kg = gather(kb, ic)
        vg = gather(vb, ic)
        qpos = q0 + jnp.arange(SLC_Q_CHUNK)
        kpos = ic[..., None] * L_SLC + jnp.arange(L_SLC)
        dist = qpos[None, None, :, None, None] - kpos
        mask = (okc[..., None] & (dist >= 0))[:, :, :, None]
        bias = tbl_g[g_idx, t5_bucket(dist)].transpose(0, 1, 2, 5, 3, 4)
        logits = jnp.einsum('bgqhd,bgqnld->bgqhnl', qc, kg).astype(jnp.float32) * scale + bias
        shp = logits.shape
        flat_mask = jnp.broadcast_to(mask, shp).reshape(shp[:4] + (n_sel * L_SLC,))
        probs = masked_softmax(logits.reshape(shp[:4] + (n_sel * L_SLC,)), flat_mask).reshape(shp)
        return jnp.einsum('bgqhnl,bgqnld->bgqhd', probs.astype(dt), vg)

    o_slc = lax.map(slc_chunk, jnp.arange(S // SLC_Q_CHUNK))
    o_slc = o_slc.transpose(1, 0, 3, 2, 4, 5).reshape(B, S, G_NSA, HPG, HEAD_DIM)

    kw_pad = jnp.pad(kw, ((0, 0), (WINDOW, 0), (0, 0), (0, 0)))
    vw_pad = jnp.pad(vw, ((0, 0), (WINDOW, 0), (0, 0), (0, 0)))
    n_keys = Q_BLOCK + WINDOW

    def win_block(i):
        q0 = i * Q_BLOCK
        qb = lax.dynamic_slice_in_dim(q, q0, Q_BLOCK, axis=1)
        kblk = lax.dynamic_slice_in_dim(kw_pad, q0, n_keys, axis=1)
        vblk = lax.dynamic_slice_in_dim(vw_pad, q0, n_keys, axis=1)
        qpos = q0 + jnp.arange(Q_BLOCK)
        kpos = q0 - WINDOW + jnp.arange(n_keys)
        dist = qpos[:, None] - kpos[None, :]
        mask = (dist >= 0) & (dist < WINDOW) & (kpos[None, :] >= 0)
        bias = rel_bias[t5_bucket(dist)].reshape(Q_BLOCK, n_keys, G_NSA, HPG).transpose(2, 3, 0, 1)
        logits = jnp.einsum('bqghd,bkgd->bghqk', qb, kblk).astype(jnp.float32) * scale + bias
        probs = masked_softmax(logits, mask)
        return jnp.einsum('bghqk,bkgd->bqghd', probs.astype(dt), vblk)

    o_win = lax.map(win_block, jnp.arange(S // Q_BLOCK))
    o_win = o_win.transpose(1, 0, 2, 3, 4, 5).reshape(B, S, G_NSA, HPG, HEAD_DIM)

    gates = jax.nn.sigmoid(gate_logit).reshape(B, S, G_NSA, HPG, 3)
    o = gates[..., 0:1] * o_cmp + gates[..., 1:2] * o_slc + gates[..., 2:3] * o_win
    return o.reshape(B, S, C_NSA)


def conv_ffn(h, w_up, conv_w, conv_b, w_down):
    S = h.shape[1]
    u = h @ w_up
    u_pad = jnp.pad(u, ((0, 0), (CONV_W - 1, 0), (0, 0)))
    u = conv_b + sum(conv_w[j] * u_pad[:, j:j + S] for j in range(CONV_W))
    gate, val = jnp.split(u, 2, axis=-1)
    return (jax.nn.silu(gate) * val) @ w_down


def setup_inputs(seed: int = 0) -> dict:
    key = jax.random.key(seed)
    ks = iter(jax.random.split(key, 40))

    def nrm(shape, scale):
        return scale * jax.random.normal(next(ks), shape, jnp.float32)

    L, D = DEPTH, D_MODEL
    return {
        "x": nrm((BATCH, SEQ, D), 1.0),
        "c": nrm((BATCH, D), 1.0),
        "ada_w": nrm((L, D, 6 * D), 0.5 * D ** -0.5),
        "ada_b": nrm((L, 6 * D), 0.1),
        "norm_g": 1.0 + nrm((L, 4, D), 0.02),
        "w_in": nrm((L, D, N_IN), D ** -0.5),
        "rwkv_mu": 0.5 + nrm((L, N_RWKV_IN), 0.1),
        "rwkv_w0": nrm((L, C_RWKV), 0.5),
        "rwkv_w_up": nrm((L, R_DECAY, C_RWKV), 0.5 * R_DECAY ** -0.5),
        "rwkv_a0": nrm((L, C_RWKV), 0.3),
        "rwkv_a_up": nrm((L, R_AAA, C_RWKV), 0.5 * R_AAA ** -0.5),
        "rwkv_g_up": nrm((L, R_GATE, C_RWKV), R_GATE ** -0.5),
        "rwkv_k_k": 0.85 + nrm((L, C_RWKV), 0.05),
        "rwkv_k_a": 1.0 + nrm((L, C_RWKV), 0.05),
        "rwkv_r_k": nrm((L, H_RWKV, HEAD_DIM), 0.1),
        "rwkv_ln_w": 1.0 + nrm((L, C_RWKV), 0.02),
        "rwkv_ln_b": nrm((L, C_RWKV), 0.02),
        "fox_b_f": 3.0 + nrm((L, H_FOX), 0.5),
        "nsa_pe_k": nrm((L, L_CMP, HEAD_DIM), 0.1),
        "nsa_pe_v": nrm((L, L_CMP, HEAD_DIM), 0.1),
        "nsa_ck_w1": nrm((L, L_CMP * HEAD_DIM, CMP_HID), (L_CMP * HEAD_DIM) ** -0.5),
        "nsa_ck_w2": nrm((L, CMP_HID, HEAD_DIM), CMP_HID ** -0.5),
        "nsa_cv_w1": nrm((L, L_CMP * HEAD_DIM, CMP_HID), (L_CMP * HEAD_DIM) ** -0.5),
        "nsa_cv_w2": nrm((L, CMP_HID, HEAD_DIM), CMP_HID ** -0.5),
        "rel_bias": nrm((NUM_BUCKETS, H_NSA), 0.5),
        "w_out": nrm((L, D_MIX, D), D_MIX ** -0.5),
        "ffn_up": nrm((L, D, 2 * D_FF), D ** -0.5),
        "ffn_conv_w": nrm((L, CONV_W, 2 * D_FF), 0.3).at[:, -1].add(1.0),
        "ffn_conv_b": nrm((L, 2 * D_FF), 0.02),
        "ffn_down": nrm((L, D_FF, D), D_FF ** -0.5),
    }


def reference(x, c, ada_w, ada_b, norm_g, w_in, rwkv_mu, rwkv_w0, rwkv_w_up, rwkv_a0,
              rwkv_a_up, rwkv_g_up, rwkv_k_k, rwkv_k_a, rwkv_r_k, rwkv_ln_w, rwkv_ln_b,
              fox_b_f, nsa_pe_k, nsa_pe_v, nsa_ck_w1, nsa_ck_w2, nsa_cv_w1, nsa_cv_w2,
              rel_bias, w_out, ffn_up, ffn_conv_w, ffn_conv_b, ffn_down):
    for l in range(DEPTH):
        mod = jax.nn.silu(c) @ ada_w[l] + ada_b[l]
        sh_m, sc_m, g_m, sh_f, sc_f, g_f = jnp.split(mod[:, None, :], 6, axis=-1)

        h = rmsnorm(x, norm_g[l, 0]) * (1.0 + sc_m) + sh_m
        p = h @ w_in[l]
        p_a, p_b, p_c = split_cols(p, (N_RWKV_IN, N_FOX_IN, N_NSA_IN))
        y_a = rwkv7_mix(p_a, rwkv_mu[l], rwkv_w0[l], rwkv_w_up[l], rwkv_a0[l], rwkv_a_up[l],
                        rwkv_g_up[l], rwkv_k_k[l], rwkv_k_a[l], rwkv_r_k[l],
                        rwkv_ln_w[l], rwkv_ln_b[l])
        y_b = fox_mix(p_b, fox_b_f[l])
        y_c = nsa_mix(p_c, nsa_pe_k[l], nsa_pe_v[l], nsa_ck_w1[l], nsa_ck_w2[l],
                      nsa_cv_w1[l], nsa_cv_w2[l], rel_bias)
        y = jnp.concatenate([y_a, y_b, y_c], axis=-1) @ w_out[l]
        x = x + g_m * rmsnorm(y, norm_g[l, 1])

        h = rmsnorm(x, norm_g[l, 2]) * (1.0 + sc_f) + sh_f
        f = conv_ffn(h, ffn_up[l], ffn_conv_w[l], ffn_conv_b[l], ffn_down[l])
        x = x + g_f * rmsnorm(f, norm_g[l, 3])
    return x
```

```cpp
#include <hip/hip_runtime.h>
#include <hip/hip_cooperative_groups.h>
#include <stdint.h>
#include <cstdio>
namespace cg = cooperative_groups;

#ifndef SINGLE_LAUNCH
#define SINGLE_LAUNCH 1
#endif

#define DEV __device__ __forceinline__
typedef unsigned short bf16_t;
typedef short bf16x8 __attribute__((ext_vector_type(8)));
typedef short bf16x4 __attribute__((ext_vector_type(4)));
typedef float f32x4 __attribute__((ext_vector_type(4)));
typedef unsigned u32x4 __attribute__((ext_vector_type(4)));
typedef unsigned u32x2 __attribute__((ext_vector_type(2)));
typedef unsigned long long u64;

constexpr int S = 4096, T = 32768, D = 1024;
constexpr int NIN = 3224, NINP = 3328;
constexpr int LDP16 = 1664;
constexpr int C_FQ = 0, C_FK = 384, C_NQ = 768, C_KC = 1152, C_VC = 1280, C_KS = 1408, C_KW = 1536;
constexpr int DFF = 2816;
constexpr int LDSB = 2 * 18432 + 512 + 32768;
constexpr float LOG2E = 1.4426950408889634f;
constexpr float QSCALE = 0.125f * LOG2E;
constexpr float NEGM = -1e30f;
constexpr float MINIT = -1e20f;

struct Params {
  const float *x, *c, *ada_w, *ada_b, *norm_g, *w_in, *mu, *w0, *w_up, *a0, *a_up, *g_up, *k_k, *k_a, *r_k, *ln_w, *ln_b,
      *b_f, *pe_k, *pe_v, *ck_w1, *ck_w2, *cv_w1, *cv_w2, *rel_bias, *w_out, *ffn_up, *conv_w, *conv_b, *ffn_down;
  float* xo;
  unsigned* bar;
  bf16_t *Wt_in, *Wt_out, *Wt_up, *Wt_down, *Wc1, *Wc2;
  float *mod, *pebias, *pepart, *lut, *kbias, *BS;
  u64* selmask;
  bf16_t *Hc, *Kc, *VtC;
  bf16_t* H;
  float *P32, *ybuf, *yscan; bf16_t *ocmp, *oslc;
  bf16_t* Prkv;
  bf16_t *P16, *VtF, *VtS, *VtW;
  float* PG;
  bf16_t *SC, *SV, *SG;
  bf16_t* act;
  int ph0, ph1;
};

DEV int opq_tid() { int v = threadIdx.x; asm volatile("" : "+v"(v)); return v; }
#define TIDX opq_tid()
typedef float f32x2 __attribute__((ext_vector_type(2)));
typedef __bf16 bf16x2v __attribute__((ext_vector_type(2)));
DEV unsigned cvt_pk_bf16(float lo, float hi) { f32x2 v = {lo, hi}; bf16x2v r = __builtin_convertvector(v, bf16x2v); return __builtin_bit_cast(unsigned, r); }
DEV bf16_t f2bf(float f) { return (bf16_t)(cvt_pk_bf16(f, 0.f) & 0xffffu); }
DEV float bf2f(bf16_t v) { return __uint_as_float(((unsigned)v) << 16); }
DEV float fexp2(float x) { return __builtin_amdgcn_exp2f(x); }
DEV float frcp(float x) { return __builtin_amdgcn_rcpf(x); }
DEV float fsigmoid(float x) { return frcp(1.f + __expf(-x)); }
DEV float fsoftplus(float x) { return fmaxf(x, 0.f) + __logf(1.f + __expf(-fabsf(x))); }
DEV float dpp_sum16(float x) {
  int v;
  v = __builtin_amdgcn_mov_dpp(__float_as_int(x), 0xB1, 0xF, 0xF, true); x += __int_as_float(v);
  v = __builtin_amdgcn_mov_dpp(__float_as_int(x), 0x4E, 0xF, 0xF, true); x += __int_as_float(v);
  v = __builtin_amdgcn_mov_dpp(__float_as_int(x), 0x124, 0xF, 0xF, true); x += __int_as_float(v);
  v = __builtin_amdgcn_mov_dpp(__float_as_int(x), 0x128, 0xF, 0xF, true); x += __int_as_float(v);
  return x;
}
DEV float wave_sum(float v) {
  v = dpp_sum16(v);
  const float a = __int_as_float(__builtin_amdgcn_readlane(__float_as_int(v), 0)), b = __int_as_float(__builtin_amdgcn_readlane(__float_as_int(v), 16));
  const float c = __int_as_float(__builtin_amdgcn_readlane(__float_as_int(v), 32)), d = __int_as_float(__builtin_amdgcn_readlane(__float_as_int(v), 48));
  return (a + b) + (c + d);
}
DEV int t5_bucket(int n) {
  if (n < 0) n = 0;
  if (n < 16) return n;
  float nf = (float)n;
  int large = 16 + (int)(logf(nf / 16.f) / 2.0794415416798357f * 16.f);
  return large < 31 ? large : 31;
}

template <class Map>
DEV void cvt_tile(const float* src, int lds_ld, bf16_t* dst, int Kd, int n0, int k0, Map map, char* lds) {
  float* sm = (float*)lds;
  const int tid = TIDX, tx = tid & 63, ty = tid >> 6;
  const int sc = map(n0 + tx);
  __syncthreads();
  float tv[16];
#pragma unroll
  for (int i = 0; i < 16; ++i) tv[i] = sc >= 0 ? src[(size_t)(k0 + ty + 4 * i) * lds_ld + sc] : 0.f;
#pragma unroll
  for (int i = 0; i < 16; ++i) sm[(ty + 4 * i) * 65 + tx] = tv[i];
  __syncthreads();
#pragma unroll
  for (int i = 0; i < 16; ++i) {
    int nn = ty + 4 * i;
    dst[(size_t)(n0 + nn) * Kd + k0 + tx] = f2bf(sm[tx * 65 + nn]);
  }
}
DEV int map_in(int n) { return n < 2048 ? n : (n < 3200 ? 2054 + (n - 2048) : (n < 3206 ? 2048 + (n - 3200) : (n < 3224 ? n : -1))); }
DEV int map_up(int n) { int j = n >> 7, c = n & 127; return c < 64 ? 64 * j + c : DFF + 64 * j + (c - 64); }

constexpr int CV_IN = 52 * 16, CV_OUT = 16 * 16, CV_UP = 88 * 16, CV_DOWN = 16 * 44, CV_C1 = 2 * 2 * 32, CV_C2 = 2 * 2 * 2;
DEV void cvt_in_item(const Params& p, int l, int it, char* lds) {
  int nt = it / 16, kt = it % 16;
  cvt_tile(p.w_in + (size_t)l * D * NIN, NIN, p.Wt_in, D, nt * 64, kt * 64, [](int n) __attribute__((always_inline)) { return map_in(n); }, lds);
}
DEV void cvt_out_item(const Params& p, int l, int it, char* lds) {
  int nt = it / 16, kt = it % 16;
  cvt_tile(p.w_out + (size_t)l * D * D, D, p.Wt_out, D, nt * 64, kt * 64, [](int n) __attribute__((always_inline)) { return n; }, lds);
}
DEV void cvt_up_item(const Params& p, int l, int it, char* lds) {
  int nt = it / 16, kt = it % 16;
  cvt_tile(p.ffn_up + (size_t)l * D * 2 * DFF, 2 * DFF, p.Wt_up, D, nt * 64, kt * 64, [](int n) __attribute__((always_inline)) { return map_up(n); }, lds);
}
DEV void cvt_down_item(const Params& p, int l, int it, char* lds) {
  int nt = it / 44, kt = it % 44;
  cvt_tile(p.ffn_down + (size_t)l * DFF * D, D, p.Wt_down, DFF, nt * 64, kt * 64, [](int n) __attribute__((always_inline)) { return n; }, lds);
}
DEV void cvt_c1_item(const Params& p, int l, int it, char* lds) {
  int kv = it / 64, r = it % 64, nt = r / 32, kt = r % 32;
  const float* src = (kv ? p.cv_w1 : p.ck_w1) + (size_t)l * 2048 * 128;
  cvt_tile(src, 128, p.Wc1 + (size_t)kv * 128 * 2048, 2048, nt * 64, kt * 64, [](int n) __attribute__((always_inline)) { return n; }, lds);
}
DEV void cvt_c2_item(const Params& p, int l, int it, char* lds) {
  int kv = it / 4, r = it % 4, nt = r / 2, kt = r % 2;
  const float* src = (kv ? p.cv_w2 : p.ck_w2) + (size_t)l * 128 * 64;
  cvt_tile(src, 64, p.Wc2 + (size_t)kv * 128 * 128, 128, nt * 64, kt * 64, [](int n) __attribute__((always_inline)) { return n < 64 ? n : -1; }, lds);
}

DEV void mod_item(const Params& p, int it, char* lds) {
  float* sc = (float*)lds;
  float* red = sc + 8192;
  const int tid = TIDX, cx = tid & 63, kq = tid >> 6;
  const int l = it / 96, n = (it % 96) * 64 + cx;
  __syncthreads();
  for (int i = tid; i < 8192; i += 256) { float v = p.c[i]; sc[i] = v / (1.f + __expf(-v)); }
  __syncthreads();
  float acc[8];
#pragma unroll
  for (int b = 0; b < 8; ++b) acc[b] = 0.f;
  const float* w = p.ada_w + (size_t)l * D * 6144 + n;
#pragma unroll 32
  for (int k = kq * 256; k < kq * 256 + 256; ++k) {
    float wv = w[(size_t)k * 6144];
#pragma unroll
    for (int b = 0; b < 8; ++b) acc[b] += sc[b * 1024 + k] * wv;
  }
#pragma unroll
  for (int b = 0; b < 8; ++b) red[(kq * 8 + b) * 64 + cx] = acc[b];
  __syncthreads();
  if (kq == 0) {
#pragma unroll
    for (int b = 0; b < 8; ++b) {
      float v = red[b * 64 + cx] + red[(8 + b) * 64 + cx] + red[(16 + b) * 64 + cx] + red[(24 + b) * 64 + cx];
      p.mod[((size_t)l * 8 + b) * 6144 + n] = v + p.ada_b[(size_t)l * 6144 + n];
    }
  }
}
DEV void pebias_item(const Params& p, int it, char* lds) {
  float* red = (float*)lds;
  const int tid = TIDX, n = tid & 127, hf = tid >> 7;
  const int lk = it >> 4, kc = it & 15, l = lk >> 1, kv = lk & 1;
  const float* pe = (kv ? p.pe_v : p.pe_k) + (size_t)l * 2048;
  const float* w = (kv ? p.cv_w1 : p.ck_w1) + (size_t)l * 2048 * 128;
  float acc = 0.f;
  const int k0 = kc * 128 + hf * 64;
#pragma unroll 16
  for (int k = k0; k < k0 + 64; ++k) acc += pe[k] * w[(size_t)k * 128 + n];
  __syncthreads();
  red[tid] = acc;
  __syncthreads();
  if (hf == 0) p.pepart[(size_t)it * 128 + n] = red[n] + red[128 + n];
}
DEV void pebias_final(const Params& p) {
  const int tid = TIDX;
  for (int o = tid; o < 8 * 128; o += 256) {
    const int lk = o >> 7, n = o & 127; float a = 0.f;
#pragma unroll
    for (int kc = 0; kc < 16; ++kc) a += p.pepart[(size_t)(lk * 16 + kc) * 128 + n];
    p.pebias[o] = a;
  }
}
DEV void lut_item(const Params& p) {
  const int tid = TIDX;
  if (tid < 128) {
    int bk = t5_bucket(tid);
#pragma unroll
    for (int h = 0; h < 6; ++h) p.lut[h * 128 + tid] = p.rel_bias[bk * 6 + h] * LOG2E;
  }
}

DEV void norm_rows(const bf16_t* y, const float* gy, const float* modgate  ,
                   const float* xin, float* xout, const float* gh, const float* modsc, const float* modsh, bf16_t* hout) {
  const int lane = TIDX & 63, wid = TIDX >> 6;
  const int nw = gridDim.x * 4;
  constexpr int U = 2;
  for (int row0 = blockIdx.x * 4 + wid; row0 < T; row0 += U * nw) {
    f32x4 xv[U][4], yv[U][4];
#pragma unroll
    for (int u = 0; u < U; ++u) {
      const int row = row0 + u * nw;
#pragma unroll
      for (int i = 0; i < 4; ++i) xv[u][i] = *(const f32x4*)(xin + (size_t)row * D + i * 256 + lane * 4);
      if (y) {
#pragma unroll
        for (int i = 0; i < 4; ++i) { u32x2 w = *(const u32x2*)(y + (size_t)row * D + i * 256 + lane * 4);
          yv[u][i] = (f32x4){__uint_as_float(w.x << 16), __uint_as_float(w.x & 0xffff0000u), __uint_as_float(w.y << 16), __uint_as_float(w.y & 0xffff0000u)}; }
      }
    }
#pragma unroll
    for (int u = 0; u < U; ++u) {
      const int row = row0 + u * nw; const int b = row >> 12;
      if (y) {
        float ss = 0.f;
#pragma unroll
        for (int i = 0; i < 4; ++i) ss += yv[u][i][0] * yv[u][i][0] + yv[u][i][1] * yv[u][i][1] + yv[u][i][2] * yv[u][i][2] + yv[u][i][3] * yv[u][i][3];
        ss = wave_sum(ss);
        const float rs = rsqrtf(ss * (1.f / 1024.f) + 1e-6f);
#pragma unroll
        for (int i = 0; i < 4; ++i) {
          f32x4 g = *(const f32x4*)(gy + i * 256 + lane * 4);
          f32x4 mg = *(const f32x4*)(modgate + (size_t)b * 6144 + i * 256 + lane * 4);
          xv[u][i] = xv[u][i] + mg * (yv[u][i] * rs * g);
        }
      }
      if (xout) {
#pragma unroll
        for (int i = 0; i < 4; ++i) *(f32x4*)(xout + (size_t)row * D + i * 256 + lane * 4) = xv[u][i];
      }
      if (hout) {
        float ss = 0.f;
#pragma unroll
        for (int i = 0; i < 4; ++i) ss += xv[u][i][0] * xv[u][i][0] + xv[u][i][1] * xv[u][i][1] + xv[u][i][2] * xv[u][i][2] + xv[u][i][3] * xv[u][i][3];
        ss = wave_sum(ss);
        const float rs = rsqrtf(ss * (1.f / 1024.f) + 1e-6f);
#pragma unroll
        for (int i = 0; i < 4; ++i) {
          f32x4 g = *(const f32x4*)(gh + i * 256 + lane * 4);
          f32x4 sc = *(const f32x4*)(modsc + (size_t)b * 6144 + i * 256 + lane * 4);
          f32x4 sh = *(const f32x4*)(modsh + (size_t)b * 6144 + i * 256 + lane * 4);
          f32x4 hv = (xv[u][i] * rs * g) * (sc + 1.f) + sh;
          u32x2 w; w.x = cvt_pk_bf16(hv[0], hv[1]); w.y = cvt_pk_bf16(hv[2], hv[3]);
          *(u32x2*)(hout + (size_t)row * D + i * 256 + lane * 4) = w;
        }
      }
    }
  }
}

constexpr int LS = 72;
DEV void glds16(const void* gsrc, unsigned lds_dst) {
  unsigned keep;
  asm volatile("s_mov_b32 %0, m0\n\ts_mov_b32 m0, %2\n\ts_nop 0\n\tglobal_load_lds_dwordx4 %1, off\n\ts_mov_b32 m0, %0" : "=&s"(keep) : "v"(gsrc), "s"(lds_dst) : "memory");
}
DEV int grow(int tid) { return (tid >> 6) * 32 + ((tid & 63) >> 3); }
DEV int gchunk(int tid) { return (tid & 7) ^ ((tid & 63) >> 3); }
template <bool SWAP, class Epi>
DEV void gemm128(const bf16_t* (&ab)[4], long akstep, const bf16_t* (&bb)[4], long bkstep, int nk, char* lds, Epi&& epi) {
  const int tid = TIDX, lane = tid & 63, wid = __builtin_amdgcn_readfirstlane(tid >> 6), wm = wid >> 1, wn = wid & 1, fr = lane & 15, fq = lane >> 4;
  const unsigned lbase = (unsigned)(size_t)((__attribute__((address_space(3))) char*)lds) + (unsigned)wid * 4096u;
  const int ra0 = (wm * 64 + fr) * 128, rb0 = 16384 + (wn * 64 + fr) * 128;
  const int sw0 = ((fq) ^ (fr & 7)) << 4, sw1 = ((4 + fq) ^ (fr & 7)) << 4;
  f32x4 acc[4][4];
#pragma unroll
  for (int m = 0; m < 4; ++m)
#pragma unroll
    for (int n = 0; n < 4; ++n) acc[m][n] = (f32x4){0.f, 0.f, 0.f, 0.f};
  auto issue = [&](int t) __attribute__((always_inline)) {
    const unsigned st = lbase + (unsigned)(t & 1) * 32768u;
#pragma unroll
    for (int i = 0; i < 4; ++i) { glds16(ab[i] + (long)t * akstep, st + i * 1024u); glds16(bb[i] + (long)t * bkstep, st + 16384u + i * 1024u); }
  };
  __syncthreads();
  issue(0);
  if (nk > 1) issue(1);
  for (int kt = 0; kt < nk; ++kt) {
    if (kt + 1 < nk) asm volatile("s_waitcnt vmcnt(8)" ::: "memory"); else asm volatile("s_waitcnt vmcnt(0)" ::: "memory");
    __builtin_amdgcn_s_barrier();
    asm volatile("" ::: "memory");
    const char* cur = lds + (kt & 1) * 32768;
#pragma unroll
    for (int ks = 0; ks < 2; ++ks) {
      const int sw = ks ? sw1 : sw0;
      bf16x8 af[4], bfr[4];
#pragma unroll
      for (int m = 0; m < 4; ++m) af[m] = *(const bf16x8*)(cur + ra0 + m * 2048 + sw);
#pragma unroll
      for (int n = 0; n < 4; ++n) bfr[n] = *(const bf16x8*)(cur + rb0 + n * 2048 + sw);
#pragma unroll
      for (int m = 0; m < 4; ++m)
#pragma unroll
        for (int n = 0; n < 4; ++n)
          acc[m][n] = SWAP ? __builtin_amdgcn_mfma_f32_16x16x32_bf16(bfr[n], af[m], acc[m][n], 0, 0, 0)
                           : __builtin_amdgcn_mfma_f32_16x16x32_bf16(af[m], bfr[n], acc[m][n], 0, 0, 0);
    }
    asm volatile("s_waitcnt lgkmcnt(0)" ::: "memory");
    __builtin_amdgcn_s_barrier();
    asm volatile("" ::: "memory");
    if (kt + 2 < nk) issue(kt + 2);
  }
  epi(acc, wm, wn, fr, fq);
}

DEV void gemm_in_item(const Params& p, int item, char* lds) {
  const int mt = item / 26, j = item % 26;
  const int tid = TIDX, lrow = grow(tid), lkc = gchunk(tid);
  const bf16_t* ab[4]; const bf16_t* bb[4];
#pragma unroll
  for (int i = 0; i < 4; ++i) {
    ab[i] = p.H + (size_t)(mt * 128 + lrow + 8 * i) * D + lkc * 8;
    bb[i] = p.Wt_in + (size_t)(j * 128 + lrow + 8 * i) * D + lkc * 8;
  }
  const int row0 = mt * 128;
  const bool vt = (j >= 13 && j <= 15) || j == 22 || j == 24;
  if (vt) {
    bf16_t* base; int nh;
    int hc0;
    if (j <= 15) { base = p.VtF; nh = 6; hc0 = (j - 13) * 128; } else if (j == 22) { base = p.VtS; nh = 2; hc0 = 0; } else { base = p.VtW; nh = 2; hc0 = 0; }
    gemm128<false>(ab, 64, bb, 64, 16, lds, [&](f32x4 (&acc)[4][4], int wm, int wn, int fr, int fq) {
#pragma unroll
      for (int m = 0; m < 4; ++m)
#pragma unroll
        for (int n = 0; n < 4; ++n) {
          int tok = row0 + wm * 64 + m * 16 + fq * 4; int b = tok >> 12, s = tok & 4095;
          int hc = hc0 + wn * 64 + n * 16 + fr; int hd = hc >> 6, d = hc & 63;
          u32x2 w; w.x = cvt_pk_bf16(acc[m][n][0], acc[m][n][1]); w.y = cvt_pk_bf16(acc[m][n][2], acc[m][n][3]);
          *(u32x2*)(base + ((size_t)(b * nh + hd) * 64 + d) * S + s) = w;
        }
    });
  } else if (j == 6 || j == 25) {
    float* base; int ld, c0, cmax;
    if (j == 6) { base = p.P32; ld = 128; c0 = 0; cmax = 128; } else { base = p.PG; ld = 32; c0 = 0; cmax = 32; }
    gemm128<true>(ab, 64, bb, 64, 16, lds, [&](f32x4 (&acc)[4][4], int wm, int wn, int fr, int fq) {
#pragma unroll
      for (int m = 0; m < 4; ++m)
#pragma unroll
        for (int n = 0; n < 4; ++n) {
          int tok = row0 + wm * 64 + m * 16 + fr; int col = c0 + wn * 64 + n * 16 + fq * 4;
          if (col < cmax) *(f32x4*)(base + (size_t)tok * ld + col) = acc[m][n];
        }
    });
  } else {
    int c0; bf16_t* ob = p.P16; int old_ = LDP16;
    if (j < 6) { ob = p.Prkv; old_ = 768; c0 = j * 128; }
    else if (j <= 12) c0 = (j - 7) * 128;
    else if (j <= 18) c0 = C_NQ + (j - 16) * 128;
    else if (j == 19) c0 = C_KC; else if (j == 20) c0 = C_VC; else if (j == 21) c0 = C_KS; else c0 = C_KW;
    const float qs = ((j >= 7 && j <= 9) || (j >= 16 && j <= 18)) ? QSCALE : 1.f;
    gemm128<true>(ab, 64, bb, 64, 16, lds, [&](f32x4 (&acc)[4][4], int wm, int wn, int fr, int fq) {
#pragma unroll
      for (int m = 0; m < 4; ++m)
#pragma unroll
        for (int n = 0; n < 4; ++n) {
          int tok = row0 + wm * 64 + m * 16 + fr; int col = c0 + wn * 64 + n * 16 + fq * 4;
          u32x2 w; w.x = cvt_pk_bf16(acc[m][n][0] * qs, acc[m][n][1] * qs); w.y = cvt_pk_bf16(acc[m][n][2] * qs, acc[m][n][3] * qs);
          *(u32x2*)(ob + (size_t)tok * old_ + col) = w;
        }
    });
  }
}
DEV void gemm_f32_item(const Params& p, const bf16_t* A, int K, const bf16_t* Bt, bf16_t* out, int item, char* lds) {
  const int mt = item >> 3, nt = item & 7;
  const int tid = TIDX, lrow = grow(tid), lkc = gchunk(tid);
  const bf16_t* ab[4]; const bf16_t* bb[4];
#pragma unroll
  for (int i = 0; i < 4; ++i) {
    ab[i] = A + (size_t)(mt * 128 + lrow + 8 * i) * K + lkc * 8;
    bb[i] = Bt + (size_t)(nt * 128 + lrow + 8 * i) * K + lkc * 8;
  }
  gemm128<true>(ab, 64, bb, 64, K / 64, lds, [&](f32x4 (&acc)[4][4], int wm, int wn, int fr, int fq) {
#pragma unroll
    for (int m = 0; m < 4; ++m)
#pragma unroll
      for (int n = 0; n < 4; ++n) {
        int tok = mt * 128 + wm * 64 + m * 16 + fr; int col = nt * 128 + wn * 64 + n * 16 + fq * 4;
        u32x2 w; w.x = cvt_pk_bf16(acc[m][n][0], acc[m][n][1]); w.y = cvt_pk_bf16(acc[m][n][2], acc[m][n][3]);
        *(u32x2*)(out + (size_t)tok * D + col) = w;
      }
  });
}
DEV void gemm_up_item(const Params& p, int l, int item, char* lds) {
  const int mtile = item / 44, j = item % 44;
  const int b = mtile / 33, i33 = mtile % 33;
  const int pos0 = 126 * i33 - 2;
  const int tid = TIDX, lrow = grow(tid), lkc = gchunk(tid);
  const bf16_t* ab[4]; const bf16_t* bb[4];
#pragma unroll
  for (int i = 0; i < 4; ++i) {
    int pos = pos0 + lrow + 8 * i; pos = pos < 0 ? 0 : (pos > S - 1 ? S - 1 : pos);
    ab[i] = p.H + (size_t)(b * S + pos) * D + lkc * 8;
    bb[i] = p.Wt_up + (size_t)(j * 128 + lrow + 8 * i) * D + lkc * 8;
  }
  float* su = (float*)lds;
  gemm128<true>(ab, 64, bb, 64, 16, lds, [&](f32x4 (&acc)[4][4], int wm, int wn, int fr, int fq) {
    __syncthreads();
#pragma unroll
    for (int m = 0; m < 4; ++m)
#pragma unroll
      for (int n = 0; n < 4; ++n) {
        int r = wm * 64 + m * 16 + fr; int col = wn * 64 + n * 16 + fq * 4;
        *(f32x4*)(su + r * 132 + col) = acc[m][n];
      }
  });
  __syncthreads();
  const int c = tid & 63, rg = tid >> 6;
  const float* cw = p.conv_w + (size_t)l * 3 * 2 * DFF; const float* cb = p.conv_b + (size_t)l * 2 * DFF;
  const int gc = 64 * j + c, vc = DFF + 64 * j + c;
  const float g0 = cw[gc], g1 = cw[2 * DFF + gc], g2 = cw[4 * DFF + gc], gb = cb[gc];
  const float v0 = cw[vc], v1 = cw[2 * DFF + vc], v2 = cw[4 * DFF + vc], vb = cb[vc];
  {
    const int r0 = 2 + rg * 32, r1 = (r0 + 32) < 128 ? (r0 + 32) : 128;
    float ug0 = (pos0 + r0 - 2 >= 0) ? su[(r0 - 2) * 132 + c] : 0.f, uv0 = (pos0 + r0 - 2 >= 0) ? su[(r0 - 2) * 132 + 64 + c] : 0.f;
    float ug1 = (pos0 + r0 - 1 >= 0) ? su[(r0 - 1) * 132 + c] : 0.f, uv1 = (pos0 + r0 - 1 >= 0) ? su[(r0 - 1) * 132 + 64 + c] : 0.f;
    bf16_t* op = p.act + (size_t)(b * S + pos0 + r0) * DFF + 64 * j + c;
    const int rend = (S - pos0) < r1 ? (S - pos0) : r1;
#pragma unroll 4
    for (int r = r0; r < rend; ++r) {
      const float ug2 = su[r * 132 + c], uv2 = su[r * 132 + 64 + c];
      const float g = gb + g0 * ug0 + g1 * ug1 + g2 * ug2;
      const float v = vb + v0 * uv0 + v1 * uv1 + v2 * uv2;
      *op = f2bf(g * frcp(1.f + __expf(-g)) * v);
      op += DFF;
      ug0 = ug1; ug1 = ug2; uv0 = uv1; uv1 = uv2;
    }
  }
  __syncthreads();
}
DEV float gelu_tanh(float x) { float u = 0.7978845608028654f * (x + 0.044715f * x * x * x); float t = 1.f - 2.f / (1.f + __expf(2.f * u)); return 0.5f * x * (1.f + t); }
DEV void gemm_c1_item(const Params& p, int l, int item, char* lds) {
  const int kv = item >> 5, mt = item & 31;
  const int tid = TIDX, lrow = grow(tid), lkc = gchunk(tid);
  const bf16_t* ab[4]; const bf16_t* bb[4];
#pragma unroll
  for (int i = 0; i < 4; ++i) {
    int r = mt * 128 + lrow + 8 * i; int b = r >> 9, g = (r >> 8) & 1, c = r & 255;
    int tk = 16 * c; if (tk > S - 32) tk = S - 32;
    ab[i] = p.P16 + (size_t)(b * S + tk) * LDP16 + (kv ? C_VC : C_KC) + g * 64 + lkc * 8;
    bb[i] = p.Wc1 + (size_t)kv * 128 * 2048 + (size_t)(lrow + 8 * i) * 2048 + lkc * 8;
  }
  const float* pb = p.pebias + (size_t)(l * 2 + kv) * 128;
  bf16_t* out = p.Hc + (size_t)kv * 4096 * 128;
  gemm128<true>(ab, LDP16, bb, 64, 32, lds, [&](f32x4 (&acc)[4][4], int wm, int wn, int fr, int fq) {
#pragma unroll
    for (int m = 0; m < 4; ++m)
#pragma unroll
      for (int n = 0; n < 4; ++n) {
        int r = mt * 128 + wm * 64 + m * 16 + fr; int col = wn * 64 + n * 16 + fq * 4;
        f32x4 bv = *(const f32x4*)(pb + col);
        f32x4 v = acc[m][n] + bv;
        u32x2 w; w.x = cvt_pk_bf16(gelu_tanh(v[0]), gelu_tanh(v[1])); w.y = cvt_pk_bf16(gelu_tanh(v[2]), gelu_tanh(v[3]));
        *(u32x2*)(out + (size_t)r * 128 + col) = w;
      }
  });
}
DEV void gemm_c2_item(const Params& p, int item, char* lds) {
  const int kv = item >> 5, mt = item & 31;
  const int tid = TIDX, lrow = grow(tid), lkc = gchunk(tid);
  const bf16_t* ab[4]; const bf16_t* bb[4];
#pragma unroll
  for (int i = 0; i < 4; ++i) {
    ab[i] = p.Hc + (size_t)kv * 4096 * 128 + (size_t)(mt * 128 + lrow + 8 * i) * 128 + lkc * 8;
    bb[i] = p.Wc2 + (size_t)kv * 128 * 128 + (size_t)(lrow + 8 * i) * 128 + lkc * 8;
  }
  if (kv == 0) {
    gemm128<true>(ab, 64, bb, 64, 2, lds, [&](f32x4 (&acc)[4][4], int wm, int wn, int fr, int fq) {
      if (wn == 0) {
#pragma unroll
        for (int m = 0; m < 4; ++m)
#pragma unroll
          for (int n = 0; n < 4; ++n) {
            int r = mt * 128 + wm * 64 + m * 16 + fr; int col = n * 16 + fq * 4;
            u32x2 w; w.x = cvt_pk_bf16(acc[m][n][0], acc[m][n][1]); w.y = cvt_pk_bf16(acc[m][n][2], acc[m][n][3]);
            *(u32x2*)(p.Kc + (size_t)r * 64 + col) = w;
          }
      }
    });
  } else {
    gemm128<false>(ab, 64, bb, 64, 2, lds, [&](f32x4 (&acc)[4][4], int wm, int wn, int fr, int fq) {
      if (wn == 0) {
#pragma unroll
        for (int m = 0; m < 4; ++m)
#pragma unroll
          for (int n = 0; n < 4; ++n) {
            int r = mt * 128 + wm * 64 + m * 16 + fq * 4; int bg = r >> 8, c = r & 255; int d = n * 16 + fr;
            u32x2 w; w.x = cvt_pk_bf16(acc[m][n][0], acc[m][n][1]); w.y = cvt_pk_bf16(acc[m][n][2], acc[m][n][3]);
            *(u32x2*)(p.VtC + ((size_t)bg * 64 + d) * 256 + c) = w;
          }
      }
    });
  }
}

DEV void rwkv_prep_item(const Params& p, int l, int item, char* lds) {
  float* sx = (float*)lds;
  const int tid = TIDX, lane = tid & 63, hd = tid >> 6;
  const int t0 = item * 64;
  const float* mu = p.mu + (size_t)l * 896;
  __syncthreads();
#pragma unroll 8
  for (int e = tid; e < 64 * 128; e += 256) {
    int tk = e >> 7, jj = e & 127; int t = t0 + tk; int col = 768 + jj;
    float pv = p.P32[(size_t)t * 128 + jj];
    float pp = (t & 4095) ? p.P32[(size_t)(t - 1) * 128 + jj] : 0.f;
    float xs = pv + (pp - pv) * mu[col];
    sx[e] = jj < 32 ? (1.f - 2.f * frcp(1.f + __expf(2.f * xs))) : (jj < 64 ? xs : fsigmoid(xs));
  }
  __syncthreads();
  const int c = tid;
  float wu[32], au[32], gu[64];
#pragma unroll
  for (int q = 0; q < 32; ++q) { wu[q] = p.w_up[((size_t)l * 32 + q) * 256 + c]; au[q] = p.a_up[((size_t)l * 32 + q) * 256 + c]; }
#pragma unroll
  for (int q = 0; q < 64; ++q) gu[q] = p.g_up[((size_t)l * 64 + q) * 256 + c];
  const float w0 = p.w0[l * 256 + c], a0 = p.a0[l * 256 + c], kkc = p.k_k[l * 256 + c], kac = p.k_a[l * 256 + c], rkc = p.r_k[l * 256 + c];
  const float mur = mu[c], muk = mu[256 + c], muv = mu[512 + c];
  float pr = 0.f, pk = 0.f, pvv = 0.f;
  if (t0 & 4095) { pr = bf2f(p.Prkv[(size_t)(t0 - 1) * 768 + c]); pk = bf2f(p.Prkv[(size_t)(t0 - 1) * 768 + 256 + c]); pvv = bf2f(p.Prkv[(size_t)(t0 - 1) * 768 + 512 + c]); }
  float gr[4], gk[4], gv[4], nr[4], nk[4], nv[4];
#pragma unroll
  for (int u = 0; u < 4; ++u) { gr[u] = bf2f(p.Prkv[(size_t)(t0 + u) * 768 + c]); gk[u] = bf2f(p.Prkv[(size_t)(t0 + u) * 768 + 256 + c]); gv[u] = bf2f(p.Prkv[(size_t)(t0 + u) * 768 + 512 + c]); }
  for (int tk4 = 0; tk4 < 64; tk4 += 4) {
    if (tk4 + 4 < 64) {
#pragma unroll
      for (int u = 0; u < 4; ++u) { const size_t o = (size_t)(t0 + tk4 + 4 + u) * 768 + c; nr[u] = bf2f(p.Prkv[o]); nk[u] = bf2f(p.Prkv[o + 256]); nv[u] = bf2f(p.Prkv[o + 512]); }
    }
#pragma unroll
    for (int u = 0; u < 4; ++u) {
      const int tk = tk4 + u;
      const int t = t0 + tk;
      float lw = 0.f, la = 0.f, lg = 0.f;
      const f32x4* xr = (const f32x4*)(sx + tk * 128);
#pragma unroll
      for (int q = 0; q < 8; ++q) { f32x4 xv = xr[q]; lw += xv[0] * wu[q * 4] + xv[1] * wu[q * 4 + 1] + xv[2] * wu[q * 4 + 2] + xv[3] * wu[q * 4 + 3]; }
#pragma unroll
      for (int q = 0; q < 8; ++q) { f32x4 xv = xr[8 + q]; la += xv[0] * au[q * 4] + xv[1] * au[q * 4 + 1] + xv[2] * au[q * 4 + 2] + xv[3] * au[q * 4 + 3]; }
#pragma unroll
      for (int q = 0; q < 16; ++q) { f32x4 xv = xr[16 + q]; lg += xv[0] * gu[q * 4] + xv[1] * gu[q * 4 + 1] + xv[2] * gu[q * 4 + 2] + xv[3] * gu[q * 4 + 3]; }
      const float cr = gr[u], ck = gk[u], cv = gv[u];
      float r = cr + (pr - cr) * mur, k = ck + (pk - ck) * muk, v = cv + (pvv - cv) * muv;
      pr = cr; pk = ck; pvv = cv;
      float wl = -fsoftplus(-(w0 + lw)) - 0.5f;
      float e = __expf(wl);
      float a = fsigmoid(a0 + la);
      float kk = k * kkc;
      float n2 = wave_sum(kk * kk);
      float kkn = kk * __builtin_amdgcn_rsqf(fmaxf(n2, 1e-24f));
      float k2 = k * (1.f + (a - 1.f) * kac);
      float bs = wave_sum(r * k2 * rkc);
      bf16_t* sc = p.SC + ((size_t)t * 4 + hd) * 320;
      sc[lane] = f2bf(r); sc[64 + lane] = f2bf(1.f - __expf(-e)); sc[128 + lane] = f2bf(k2); sc[192 + lane] = f2bf(-kkn); sc[256 + lane] = f2bf(kkn * a);
      p.SV[(size_t)t * 256 + c] = f2bf(v);
      p.SG[(size_t)t * 256 + c] = f2bf(lg);
      if (lane == 0) p.BS[(size_t)t * 4 + hd] = bs;
    }
#pragma unroll
    for (int u = 0; u < 4; ++u) { gr[u] = nr[u]; gk[u] = nk[u]; gv[u] = nv[u]; }
  }
}
DEV void fox_cum_item(const Params& p, int l, int item, char* lds) {
  float* red = (float*)lds;
  const int tid = TIDX; const int b = item / 6, h = item % 6;
  const float bf = p.b_f[l * 6 + h];
  float v[16]; float run = 0.f;
#pragma unroll
  for (int i = 0; i < 16; ++i) {
    int s = tid * 16 + i;
    float xl = p.PG[(size_t)(b * S + s) * 32 + h] + bf;
    run += -fsoftplus(-xl);
    v[i] = run;
  }
  __syncthreads();
  red[tid] = run;
  __syncthreads();
  if (tid == 0) { float a = 0.f; for (int i = 0; i < 256; ++i) { float tmp = red[i]; red[i] = a; a += tmp; } }
  __syncthreads();
  const float off = red[tid];
#pragma unroll
  for (int i = 0; i < 16; ++i) p.kbias[(size_t)item * S + tid * 16 + i] = -(v[i] + off) * LOG2E;
  __syncthreads();
}

constexpr int SCH = 16;
DEV void scan_item(const Params& p, int item, char* lds) {
  const int bh = item >> 2, rg = item & 3, b = bh >> 2, h = bh & 3;
  const int tid = TIDX, rl = tid >> 4, kq = tid & 15;
  float* buf0 = (float*)lds; constexpr int BUFSZ = SCH * 320 + SCH * 16;
  f32x2 s01 = {0.f, 0.f}, s23 = {0.f, 0.f};
  const bf16_t* scb = p.SC + ((size_t)(b * S) * 4 + h) * 320 + (size_t)rl * 1280 + kq * 4;
  const bf16_t* svb = p.SV + (size_t)(b * S) * 256 + h * 64 + rg * 16 + (size_t)rl * 256 + kq;
  float* yb = p.yscan + (size_t)(b * S) * 256 + h * 64 + rg * 16 + rl + (size_t)kq * 256;
  u32x2 gA[5], gB[5]; bf16_t gvA, gvB;
  auto gload = [&](u32x2 (&g)[5], bf16_t& gv, int ch) __attribute__((always_inline)) {
    const size_t o = (size_t)ch * SCH * 1280;
#pragma unroll
    for (int a = 0; a < 5; ++a) g[a] = *(const u32x2*)(scb + o + a * 64);
    gv = svb[(size_t)ch * SCH * 256];
  };
  auto lstore = [&](const u32x2 (&g)[5], const bf16_t& gv, float* dst) __attribute__((always_inline)) {
#pragma unroll
    for (int a = 0; a < 5; ++a) {
      f32x4 o = {__uint_as_float(g[a].x << 16), __uint_as_float(g[a].x & 0xffff0000u), __uint_as_float(g[a].y << 16), __uint_as_float(g[a].y & 0xffff0000u)};
      if (a == 1) o = 1.f - o;
      *(f32x4*)(dst + rl * 320 + a * 64 + kq * 4) = o;
    }
    dst[SCH * 320 + kq * SCH + rl] = bf2f(gv);
  };
  constexpr int NCH = S / SCH;
  auto chunk = [&](int ch, u32x2 (&g)[5], bf16_t& gv) __attribute__((always_inline)) {
    const float* cur = buf0 + (ch & 1) * BUFSZ; float* nxt = buf0 + ((ch + 1) & 1) * BUFSZ;
    if (ch + 1 < NCH) lstore(g, gv, nxt);
    if (ch + 3 < NCH) gload(g, gv, ch + 3);
    f32x4 vr[4];
#pragma unroll
    for (int q = 0; q < 4; ++q) vr[q] = *(const f32x4*)(cur + SCH * 320 + rl * SCH + q * 4);
    float ykeep = 0.f;
    f32x4 nr4, nw4, nk4, na4, nb4;
    { const float* q = cur + kq * 4; nr4 = *(const f32x4*)(q); nw4 = *(const f32x4*)(q + 64); nk4 = *(const f32x4*)(q + 128); na4 = *(const f32x4*)(q + 192); nb4 = *(const f32x4*)(q + 256); }
#pragma unroll
    for (int st = 0; st < SCH; ++st) {
      const f32x4 r4 = nr4, w4 = nw4, k4 = nk4, a4 = na4, b4 = nb4;
      if (st + 1 < SCH) { const float* q = cur + (st + 1) * 320 + kq * 4; nr4 = *(const f32x4*)(q); nw4 = *(const f32x4*)(q + 64); nk4 = *(const f32x4*)(q + 128); na4 = *(const f32x4*)(q + 192); nb4 = *(const f32x4*)(q + 256); }
      const float vv = vr[st >> 2][st & 3];
      f32x2 t = s01 * (f32x2){a4[0], a4[1]}; t = s23 * (f32x2){a4[2], a4[3]} + t;
      f32x2 u01 = s01 * (f32x2){w4[0], w4[1]} + (f32x2){k4[0], k4[1]} * vv;
      f32x2 u23 = s23 * (f32x2){w4[2], w4[3]} + (f32x2){k4[2], k4[3]} * vv;
      float sa = dpp_sum16(t[0] + t[1]);
      s01 = (f32x2){b4[0], b4[1]} * sa + u01;
      s23 = (f32x2){b4[2], b4[3]} * sa + u23;
      f32x2 yy = s01 * (f32x2){r4[0], r4[1]}; yy = s23 * (f32x2){r4[2], r4[3]} + yy;
      const float y = dpp_sum16(yy[0] + yy[1]);
      ykeep = (kq == st) ? y : ykeep;
    }
    yb[(size_t)ch * SCH * 256] = ykeep;
    __syncthreads();
  };
  __syncthreads();
  gload(gA, gvA, 0); lstore(gA, gvA, buf0);
  gload(gB, gvB, 1); gload(gA, gvA, 2);
  __syncthreads();
  for (int ch = 0; ch < NCH; ch += 2) {
    chunk(ch, gB, gvB);
    chunk(ch + 1, gA, gvA);
  }
}
DEV void rwkv_post_item(const Params& p, int l, int item) {
  const int tid = TIDX, hd = tid >> 6, c = tid;
  const float lw = p.ln_w[l * 256 + c], lb = p.ln_b[l * 256 + c];
  for (int tk = 0; tk < 64; tk += 8) {
    float y[8], v[8], g[8], bs[8];
#pragma unroll
    for (int u = 0; u < 8; ++u) {
      const int t = item * 64 + tk + u;
      y[u] = p.yscan[(size_t)t * 256 + c]; v[u] = bf2f(p.SV[(size_t)t * 256 + c]); g[u] = bf2f(p.SG[(size_t)t * 256 + c]); bs[u] = p.BS[(size_t)t * 4 + hd];
    }
#pragma unroll
    for (int u = 0; u < 8; ++u) {
      const int t = item * 64 + tk + u;
      float mean = wave_sum(y[u]) * (1.f / 64.f);
      float dlt = y[u] - mean;
      float var = wave_sum(dlt * dlt) * (1.f / 64.f);
      float yn = dlt * rsqrtf(var + 64e-5f) * lw + lb;
      p.H[(size_t)t * D + c] = f2bf((yn + bs[u] * v[u]) * g[u]);
    }
  }
}

template <int NQ> struct AttnAcc { f32x4 o[4][NQ]; float m[NQ], l[NQ]; };
template <int NQ> DEV void attn_init(AttnAcc<NQ>& st) {
#pragma unroll
  for (int nq = 0; nq < NQ; ++nq) { st.m[nq] = MINIT; st.l[nq] = 0.f;
#pragma unroll
    for (int dt = 0; dt < 4; ++dt) st.o[dt][nq] = (f32x4){0.f, 0.f, 0.f, 0.f}; }
}
struct KVSrc { const bf16_t* K; int ldk; const bf16_t* Vt; int ldv; const float* kb; };
constexpr int KV_STAGE = 2 * 64 * LS * 2;
DEV void kv_load(const KVSrc& s, int k0, u32x4 (&rk)[2], u32x4 (&rv)[2], f32x4& rkb) {
  const int tid = TIDX;
#pragma unroll
  for (int i = 0; i < 2; ++i) {
    int ch = tid + 256 * i; int row = ch >> 3, kc = ch & 7;
    rk[i] = *(const u32x4*)(s.K + (size_t)(k0 + row) * s.ldk + kc * 8);
    rv[i] = *(const u32x4*)(s.Vt + (size_t)row * s.ldv + k0 + kc * 8);
  }
  if (s.kb && tid < 16) rkb = *(const f32x4*)(s.kb + k0 + tid * 4);
}
DEV void kv_store(char* lds, int stage, const u32x4 (&rk)[2], const u32x4 (&rv)[2], const f32x4& rkb, bool haskb) {
  const int tid = TIDX;
  bf16_t* sK = (bf16_t*)(lds + stage * KV_STAGE); bf16_t* sV = sK + 64 * LS;
#pragma unroll
  for (int i = 0; i < 2; ++i) {
    int ch = tid + 256 * i; int row = ch >> 3, kc = ch & 7;
    *(u32x4*)(sK + row * LS + kc * 8) = rk[i];
    *(u32x4*)(sV + row * LS + kc * 8) = rv[i];
  }
  if (haskb && tid < 16) *(f32x4*)(lds + 2 * KV_STAGE + stage * 256 + tid * 16) = rkb;
}
template <int NQ> DEV void qk_tile(f32x4 (&s)[4][NQ], const bf16x8 (&qf)[NQ][2], const bf16_t* sK, int fr, int fq) {
#pragma unroll
  for (int kt = 0; kt < 4; ++kt) {
#pragma unroll
    for (int nq = 0; nq < NQ; ++nq) s[kt][nq] = (f32x4){0.f, 0.f, 0.f, 0.f};
#pragma unroll
    for (int ks = 0; ks < 2; ++ks) {
      bf16x8 kf = *(const bf16x8*)(sK + (kt * 16 + fr) * LS + ks * 32 + fq * 8);
#pragma unroll
      for (int nq = 0; nq < NQ; ++nq) s[kt][nq] = __builtin_amdgcn_mfma_f32_16x16x32_bf16(kf, qf[nq][ks], s[kt][nq], 0, 0, 0);
    }
  }
}
template <int NQ, bool QLDS, class BiasF>
DEV void attn_tile_q(AttnAcc<NQ>& st, const bf16x8 (&qf)[NQ][2], const char* sQw, int qsw0, int qsw1, const bf16_t* sK, const bf16_t* sV, BiasF&& bias, int fr, int fq) {
#pragma unroll
  for (int hf = 0; hf < 2; ++hf) {
    f32x4 s[2][NQ];
#pragma unroll
    for (int k2 = 0; k2 < 2; ++k2) {
#pragma unroll
      for (int nq = 0; nq < NQ; ++nq) s[k2][nq] = (f32x4){0.f, 0.f, 0.f, 0.f};
#pragma unroll
      for (int ks = 0; ks < 2; ++ks) {
        bf16x8 kf = *(const bf16x8*)(sK + ((hf * 2 + k2) * 16 + fr) * LS + ks * 32 + fq * 8);
#pragma unroll
        for (int nq = 0; nq < NQ; ++nq) { bf16x8 qv; if (QLDS) qv = *(const bf16x8*)(sQw + nq * 2048 + (ks ? qsw1 : qsw0)); else qv = qf[nq][ks];
          s[k2][nq] = __builtin_amdgcn_mfma_f32_16x16x32_bf16(kf, qv, s[k2][nq], 0, 0, 0); }
      }
    }
    bf16x8 pf[NQ];
#pragma unroll
    for (int nq = 0; nq < NQ; ++nq) {
      s[0][nq] = bias(nq, hf * 2, s[0][nq]); s[1][nq] = bias(nq, hf * 2 + 1, s[1][nq]);
      float lm = fmaxf(fmaxf(s[0][nq][0], s[0][nq][1]), s[0][nq][2]);
      lm = fmaxf(fmaxf(lm, s[0][nq][3]), s[1][nq][0]); lm = fmaxf(fmaxf(lm, s[1][nq][1]), s[1][nq][2]); lm = fmaxf(lm, s[1][nq][3]);
      float mcur = st.m[nq], lcur = st.l[nq];
      if (__builtin_amdgcn_ballot_w64(lm > mcur + 8.f) != 0ull) {
        float mx2 = fmaxf(mcur, lm);
        mx2 = fmaxf(mx2, __shfl_xor(mx2, 16)); mx2 = fmaxf(mx2, __shfl_xor(mx2, 32));
        const float alpha = fexp2(mcur - mx2); mcur = mx2;
        lcur *= alpha;
#pragma unroll
        for (int dt = 0; dt < 4; ++dt) st.o[dt][nq] = st.o[dt][nq] * alpha;
      }
      const float mx = mcur;
      const float nmx = -mx;
      f32x4 p0 = s[0][nq] + nmx, p1 = s[1][nq] + nmx;
#pragma unroll
      for (int j = 0; j < 4; ++j) { p0[j] = fexp2(p0[j]); p1[j] = fexp2(p1[j]); }
      const f32x4 sm = p0 + p1;
      st.m[nq] = mcur; st.l[nq] = lcur + ((sm[0] + sm[1]) + (sm[2] + sm[3]));
      u32x4 w; w.x = cvt_pk_bf16(p0[0], p0[1]); w.y = cvt_pk_bf16(p0[2], p0[3]); w.z = cvt_pk_bf16(p1[0], p1[1]); w.w = cvt_pk_bf16(p1[2], p1[3]);
      pf[nq] = __builtin_bit_cast(bf16x8, w);
    }
#pragma unroll
    for (int dt = 0; dt < 4; ++dt) {
      const bf16_t* vp = sV + (dt * 16 + fr) * LS + hf * 32 + fq * 4;
      u32x2 lo = *(const u32x2*)(vp), hi = *(const u32x2*)(vp + 16);
      u32x4 w; w.x = lo.x; w.y = lo.y; w.z = hi.x; w.w = hi.y;
      bf16x8 vf = __builtin_bit_cast(bf16x8, w);
#pragma unroll
      for (int nq = 0; nq < NQ; ++nq) st.o[dt][nq] = __builtin_amdgcn_mfma_f32_16x16x32_bf16(vf, pf[nq], st.o[dt][nq], 0, 0, 0);
    }
  }
}
template <int NQ, class BiasF>
DEV void attn_tile(AttnAcc<NQ>& st, const bf16x8 (&qf)[NQ][2], const bf16_t* sK, const bf16_t* sV, BiasF&& bias, int fr, int fq) {
  attn_tile_q<NQ, false>(st, qf, nullptr, 0, 0, sK, sV, bias, fr, fq);
}
template <class Body>
DEV void kv_loop(const KVSrc& src, u64 tiles, char* lds, Body&& body) {
  u32x4 rk[2], rv[2]; f32x4 rkb = {0.f, 0.f, 0.f, 0.f};
  if (tiles == 0) return;
  const bool haskb = src.kb != nullptr;
  int kt = __builtin_ctzll(tiles); tiles &= tiles - 1;
  kv_load(src, kt * 64, rk, rv, rkb);
  __syncthreads();
  kv_store(lds, 0, rk, rv, rkb, haskb);
  int nkt = -1;
  if (tiles) { nkt = __builtin_ctzll(tiles); tiles &= tiles - 1; kv_load(src, nkt * 64, rk, rv, rkb); }
  int stage = 0;
  for (;;) {
    __syncthreads();
    int nnkt = -1;
    if (nkt >= 0) {
      kv_store(lds, stage ^ 1, rk, rv, rkb, haskb);
      if (tiles) { nnkt = __builtin_ctzll(tiles); tiles &= tiles - 1; kv_load(src, nnkt * 64, rk, rv, rkb); }
    }
    const bf16_t* sK = (const bf16_t*)(lds + stage * KV_STAGE);
    body(kt, sK, sK + 64 * LS, (const float*)(lds + 2 * KV_STAGE + stage * 256));
    if (nkt < 0) break;
    kt = nkt; nkt = nnkt; stage ^= 1;
  }
}

constexpr int FNQ = 4;
constexpr int FQT = FNQ * 64;
constexpr int FOX_ITEMS = 48 * (S / FQT);
DEV void fox_item(const Params& p, int item, char* lds) {
  const int qi = (S / FQT - 1) - item / 48, bh = item % 48, b = bh / 6, h = bh % 6;
  const int q0 = qi * FQT;
  const int tid = TIDX, lane = tid & 63, wid = __builtin_amdgcn_readfirstlane(tid >> 6), fr = lane & 15, fq = lane >> 4;
  const bf16_t* Pb = p.P16 + (size_t)b * S * LDP16;
  const int qw0 = q0 + wid * (FNQ * 16);
  char* sQ = lds + 2 * KV_STAGE + 512;
  __syncthreads();
#pragma unroll
  for (int i = 0; i < FQT * 8 / 256; ++i) {
    const int ch = tid + 256 * i, row = ch >> 3, c = ch & 7;
    *(u32x4*)(sQ + row * 128 + ((c ^ (row & 7)) << 4)) = *(const u32x4*)(Pb + (size_t)(q0 + row) * LDP16 + C_FQ + h * 64 + c * 8);
  }
  const char* sQw = sQ + (wid * (FNQ * 16) + fr) * 128;
  const int qsw0 = (fq ^ (fr & 7)) << 4, qsw1 = ((4 + fq) ^ (fr & 7)) << 4;
  bf16x8 qdummy[FNQ][2];
  AttnAcc<FNQ> st; attn_init(st);
  KVSrc src{Pb + C_FK + h * 64, LDP16, p.VtF + (size_t)(b * 6 + h) * 64 * S, S, p.kbias + (size_t)(b * 6 + h) * S};
  const int nkt = (q0 + FQT) / 64;
  const u64 tiles = nkt >= 64 ? ~0ull : ((1ull << nkt) - 1);
  kv_loop(src, tiles, lds, [&](int kt, const bf16_t* sK, const bf16_t* sV, const float* sKB) __attribute__((always_inline)) {
    if (kt * 64 > qw0 + FNQ * 16 - 1) return;
    const bool diag = kt * 64 + 63 > qw0;
    attn_tile_q<FNQ, true>(st, qdummy, sQw, qsw0, qsw1, sK, sV, [&](int nq, int k16, f32x4 raw) __attribute__((always_inline)) {
      const int kl = k16 * 16 + fq * 4;
      f32x4 kb = *(const f32x4*)(sKB + kl);
      f32x4 v = raw + kb;
      if (diag) { const int qpos = qw0 + nq * 16 + fr; const int key0 = kt * 64 + kl;
#pragma unroll
        for (int j = 0; j < 4; ++j) if (key0 + j > qpos) v[j] = NEGM; }
      return v; }, fr, fq);
  });
#pragma unroll
  for (int nq = 0; nq < FNQ; ++nq) {
    float lt = st.l[nq]; lt += __shfl_xor(lt, 16); lt += __shfl_xor(lt, 32);
    const float inv = lt > 0.f ? 1.f / lt : 0.f;
    const int tok = b * S + qw0 + nq * 16 + fr;
#pragma unroll
    for (int dt = 0; dt < 4; ++dt) {
      f32x4 o = st.o[dt][nq] * inv;
      u32x2 w; w.x = cvt_pk_bf16(o[0], o[1]); w.y = cvt_pk_bf16(o[2], o[3]);
      *(u32x2*)(p.H + (size_t)tok * D + 256 + h * 64 + dt * 16 + fq * 4) = w;
    }
  }
}

DEV void nsa_cmp_item(const Params& p, int item, char* lds) {
  const int bg = item >> 6, tile = item & 63, b = bg >> 1, g = bg & 1;
  const int t0 = tile * 64;
  const int tid = TIDX, lane = tid & 63, wid = __builtin_amdgcn_readfirstlane(tid >> 6), fr = lane & 15, fq = lane >> 4;
  float* slut = (float*)(lds + 2 * KV_STAGE + 512);
  float* simp = slut + 384;
  __syncthreads();
  for (int e = tid; e < 384; e += 256) slut[e] = p.lut[(g * 3) * 128 + e];
  for (int e = tid; e < 64 * 65; e += 256) simp[e] = 0.f;
  const bf16_t* Pb = p.P16 + (size_t)b * S * LDP16;
  const int qpos = t0 + wid * 16 + fr;
  bf16x8 qf[3][2];
#pragma unroll
  for (int nq = 0; nq < 3; ++nq)
#pragma unroll
    for (int ks = 0; ks < 2; ++ks) qf[nq][ks] = *(const bf16x8*)(Pb + (size_t)qpos * LDP16 + C_NQ + (g * 3 + nq) * 64 + ks * 32 + fq * 8);
  AttnAcc<3> st; attn_init(st);
  KVSrc src{p.Kc + (size_t)bg * 256 * 64, 64, p.VtC + (size_t)bg * 64 * 256, 256, nullptr};
  const int cmaxt = (t0 + 63 - 31) >= 0 ? (t0 + 32) / 16 : -1;
  const int nkt = cmaxt >= 0 ? (cmaxt / 64 + 1) : 0;
  const u64 tiles = nkt > 0 ? ((1ull << nkt) - 1) : 0ull;
  auto biasf = [&](int kt) __attribute__((always_inline)) {
    return [&, kt](int nq, int k16, f32x4 raw) __attribute__((always_inline)) {
      const int c0 = kt * 64 + k16 * 16 + fq * 4;
      f32x4 v;
#pragma unroll
      for (int j = 0; j < 4; ++j) { int dist = qpos - (16 * (c0 + j) + 31); int dc = dist > 127 ? 127 : dist;
        v[j] = dist >= 0 ? raw[j] + slut[nq * 128 + dc] : NEGM; }
      return v; };
  };
  kv_loop(src, tiles, lds, [&](int kt, const bf16_t* sK, const bf16_t* sV, const float*) __attribute__((always_inline)) { attn_tile<3>(st, qf, sK, sV, biasf(kt), fr, fq); });
  float linv[3];
#pragma unroll
  for (int nq = 0; nq < 3; ++nq) {
    float lt = st.l[nq]; lt += __shfl_xor(lt, 16); lt += __shfl_xor(lt, 32);
    linv[nq] = lt > 0.f ? 1.f / lt : 0.f;
    const int tok = b * S + qpos; const int hh = g * 3 + nq;
    const float gate = fsigmoid(p.PG[(size_t)tok * 32 + 6 + hh * 3 + 0]);
#pragma unroll
    for (int dt = 0; dt < 4; ++dt) { const f32x4 o = st.o[dt][nq] * (linv[nq] * gate); u32x2 w; w.x = cvt_pk_bf16(o[0], o[1]); w.y = cvt_pk_bf16(o[2], o[3]);
      *(u32x2*)(p.ocmp + (size_t)tok * 384 + hh * 64 + dt * 16 + fq * 4) = w; }
  }
  const int cur = tile;
  if (cur >= 16) {
    float carry = 0.f;
    kv_loop(src, tiles, lds, [&](int kt, const bf16_t* sK, const bf16_t* sV, const float*) __attribute__((always_inline)) {
      f32x4 s[4][3];
      qk_tile<3>(s, qf, sK, fr, fq);
      auto bf = biasf(kt);
#pragma unroll
      for (int k16 = 0; k16 < 4; ++k16) {
        f32x4 ph = (f32x4){0.f, 0.f, 0.f, 0.f};
#pragma unroll
        for (int nq = 0; nq < 3; ++nq) { f32x4 v = bf(nq, k16, s[k16][nq]);
#pragma unroll
          for (int j = 0; j < 4; ++j) ph[j] += v[j] < -1e29f ? 0.f : fexp2(v[j] - st.m[nq]) * linv[nq]; }
        const float s4 = (ph[0] + ph[1]) + (ph[2] + ph[3]);
        const float up = __shfl(ph[3], (lane + 48) & 63);
        const float upc = __shfl(carry, (lane + 48) & 63);
        const float prevp = fq == 0 ? upc : up;
        carry = ph[3];
        const int jb = kt * 16 + k16 * 4 + fq;
        simp[(wid * 16 + fr) * 65 + jb] = s4 + prevp;
      }
    });
  }
  __syncthreads();
  for (int tl = 0; tl < 16; ++tl) {
    const int tk = wid * 16 + tl;
    const int jb = lane;
    const bool valid = jb <= cur;
    const bool forced = (jb == 0) || (valid && (cur - jb) < 2);
    const float score = valid ? (forced ? 1e4f : simp[tk * 65 + jb]) : -1.f;
    int rank = 0;
#pragma unroll
    for (int j2 = 0; j2 < 64; ++j2) {
      const float s2 = __int_as_float(__builtin_amdgcn_readlane(__float_as_int(score), j2));
      rank += (s2 > score || (s2 == score && j2 < jb)) ? 1 : 0;
    }
    const bool sel = rank < 16 && score >= 0.f;
    const u64 m = __ballot(sel);
    if (lane == 0) p.selmask[(size_t)bg * S + t0 + tk] = m;
  }
  __syncthreads();
}

DEV void nsa_sw_item(const Params& p, int item, char* lds) {
  const int bg = item >> 6, tile = 63 - (item & 63), b = bg >> 1, g = bg & 1;
  const int t0 = tile * 64, cur = tile;
  const int tid = TIDX, lane = tid & 63, wid = __builtin_amdgcn_readfirstlane(tid >> 6), fr = lane & 15, fq = lane >> 4;
  float* slut = (float*)(lds + 2 * KV_STAGE + 512);
  u64* sor = (u64*)(slut + 384);
  __syncthreads();
  for (int e = tid; e < 384; e += 256) slut[e] = p.lut[(g * 3) * 128 + e];
  const bf16_t* Pb = p.P16 + (size_t)b * S * LDP16;
  const int qpos = t0 + wid * 16 + fr;
  const u64 mymask = p.selmask[(size_t)bg * S + qpos];
  { u64 m = mymask;
#pragma unroll
    for (int o = 1; o < 16; o <<= 1) { unsigned lo = __shfl_xor((unsigned)m, o), hi = __shfl_xor((unsigned)(m >> 32), o); m |= ((u64)hi << 32) | lo; }
    if (lane == 0) sor[wid] = m; }
  __syncthreads();
  const u64 umv = sor[0] | sor[1] | sor[2] | sor[3];
  const u64 um = ((u64)(unsigned)__builtin_amdgcn_readfirstlane((int)(umv >> 32)) << 32) | (u64)(unsigned)__builtin_amdgcn_readfirstlane((int)(unsigned)umv);
  bf16x8 qf[3][2];
#pragma unroll
  for (int nq = 0; nq < 3; ++nq)
#pragma unroll
    for (int ks = 0; ks < 2; ++ks) qf[nq][ks] = *(const bf16x8*)(Pb + (size_t)qpos * LDP16 + C_NQ + (g * 3 + nq) * 64 + ks * 32 + fq * 8);
  const float c31[3] = {slut[127], slut[128 + 127], slut[256 + 127]};
  {
    AttnAcc<3> st; attn_init(st);
    KVSrc src{Pb + C_KS + g * 64, LDP16, p.VtS + (size_t)bg * 64 * S, S, nullptr};
    kv_loop(src, um, lds, [&](int kt, const bf16_t* sK, const bf16_t* sV, const float*) __attribute__((always_inline)) {
      const bool mine = (mymask >> kt) & 1ull;
      const bool nearb = (cur - kt) <= 2;
      attn_tile<3>(st, qf, sK, sV, [&](int nq, int k16, f32x4 raw) __attribute__((always_inline)) {
        f32x4 v;
        if (!mine) { v = (f32x4){NEGM, NEGM, NEGM, NEGM}; }
        else if (!nearb) { v = raw + c31[nq]; }
        else {
          const int key0 = kt * 64 + k16 * 16 + fq * 4;
#pragma unroll
          for (int j = 0; j < 4; ++j) { int dist = qpos - (key0 + j); int dc = dist > 127 ? 127 : dist;
            v[j] = dist >= 0 ? raw[j] + slut[nq * 128 + dc] : NEGM; }
        }
        return v; }, fr, fq);
    });
#pragma unroll
    for (int nq = 0; nq < 3; ++nq) {
      float lt = st.l[nq]; lt += __shfl_xor(lt, 16); lt += __shfl_xor(lt, 32);
      const float inv = lt > 0.f ? 1.f / lt : 0.f;
      const int tok = b * S + qpos; const int hh = g * 3 + nq;
      const float gate = fsigmoid(p.PG[(size_t)tok * 32 + 6 + hh * 3 + 1]);
#pragma unroll
      for (int dt = 0; dt < 4; ++dt) {
        { const f32x4 o = st.o[dt][nq] * (inv * gate); u32x2 w; w.x = cvt_pk_bf16(o[0], o[1]); w.y = cvt_pk_bf16(o[2], o[3]);
          *(u32x2*)(p.oslc + (size_t)tok * 384 + hh * 64 + dt * 16 + fq * 4) = w; }
      }
    }
  }
  {
    AttnAcc<3> st; attn_init(st);
    KVSrc src{Pb + C_KW + g * 64, LDP16, p.VtW + (size_t)bg * 64 * S, S, nullptr};
    const int klo = cur - 8 < 0 ? 0 : cur - 8;
    u64 tiles = 0; for (int k = klo; k <= cur; ++k) tiles |= 1ull << k;
    kv_loop(src, tiles, lds, [&](int kt, const bf16_t* sK, const bf16_t* sV, const float*) __attribute__((always_inline)) {
      const bool nearb = (cur - kt) <= 2;
      const bool far = (cur - kt) == 8;
      attn_tile<3>(st, qf, sK, sV, [&](int nq, int k16, f32x4 raw) __attribute__((always_inline)) {
        f32x4 v;
        const int key0 = kt * 64 + k16 * 16 + fq * 4;
        if (nearb) {
#pragma unroll
          for (int j = 0; j < 4; ++j) { int dist = qpos - (key0 + j); int dc = dist > 127 ? 127 : dist;
            v[j] = dist >= 0 ? raw[j] + slut[nq * 128 + dc] : NEGM; }
        } else {
          v = raw + c31[nq];
          if (far) {
#pragma unroll
            for (int j = 0; j < 4; ++j) if (qpos - (key0 + j) >= 512) v[j] = NEGM;
          }
        }
        return v; }, fr, fq);
    });
#pragma unroll
    for (int nq = 0; nq < 3; ++nq) {
      float lt = st.l[nq]; lt += __shfl_xor(lt, 16); lt += __shfl_xor(lt, 32);
      const float inv = lt > 0.f ? 1.f / lt : 0.f;
      const int tok = b * S + qpos; const int hh = g * 3 + nq;
      const float gate = fsigmoid(p.PG[(size_t)tok * 32 + 6 + hh * 3 + 2]);
#pragma unroll
      for (int dt = 0; dt < 4; ++dt) {
        const u32x2 wc = *(const u32x2*)(p.ocmp + (size_t)tok * 384 + hh * 64 + dt * 16 + fq * 4), ws = *(const u32x2*)(p.oslc + (size_t)tok * 384 + hh * 64 + dt * 16 + fq * 4);
        f32x4 oc = (f32x4){__uint_as_float(wc.x << 16), __uint_as_float(wc.x & 0xffff0000u), __uint_as_float(wc.y << 16), __uint_as_float(wc.y & 0xffff0000u)}
                 + (f32x4){__uint_as_float(ws.x << 16), __uint_as_float(ws.x & 0xffff0000u), __uint_as_float(ws.y << 16), __uint_as_float(ws.y & 0xffff0000u)};
        f32x4 o = st.o[dt][nq] * (inv * gate) + oc;
        u32x2 w; w.x = cvt_pk_bf16(o[0], o[1]); w.y = cvt_pk_bf16(o[2], o[3]);
        *(u32x2*)(p.H + (size_t)tok * D + 640 + hh * 64 + dt * 16 + fq * 4) = w;
      }
    }
  }
  __syncthreads();
}


#define XB_TMO      128
#define XB_XCNT(j)  (256  + 64 * (j))
#define XB_XSUB(j)  (1280 + 64 * (j))
#define XB_XGEN(j)  (2304 + 64 * (j))
#define XB_TOP      3328
#define XB_TOPGEN   3392
#define XCD_BAR_WORDS 3456
#define XB_SPIN_CAP (1u << 22)
#define LAS __attribute__((address_space(3)))
DEV unsigned xb_ld(unsigned* p) { return __hip_atomic_load(p, __ATOMIC_RELAXED, __HIP_MEMORY_SCOPE_AGENT); }
DEV unsigned xb_add(unsigned* p, unsigned v) { return __hip_atomic_fetch_add(p, v, __ATOMIC_RELAXED, __HIP_MEMORY_SCOPE_AGENT); }
DEV unsigned xb_xcc_id() { return (unsigned)__builtin_amdgcn_s_getreg((3 << 11) | 20) & 0xFu; }
#define XB_SPIN(cond, bar) do { unsigned _sp = 0; while (cond) { __builtin_amdgcn_s_sleep(1); \
    if ((++_sp & 255u) == 0u) { if (xb_ld(&(bar)[XB_TMO])) break; if (_sp > XB_SPIN_CAP) { atomicAdd(&(bar)[XB_TMO], 1u); break; } } } } while (0)
struct XcdBarrier { unsigned* bar; unsigned x; volatile LAS unsigned* st; };
DEV XcdBarrier xcd_barrier_post(unsigned* bar, volatile LAS unsigned* st) {
  XcdBarrier b; b.bar = bar; b.x = xb_xcc_id(); b.st = st;
  if (threadIdx.x == 0) (void)xb_add(&bar[XB_XCNT(b.x)], 1u);
  return b;
}
DEV void xcd_barrier_complete(unsigned* bar, unsigned x, unsigned& nloc, unsigned& nx) {
  const unsigned G = gridDim.x;
  unsigned sum, cnt, mine, sp = 0u;
  for (;;) {
    sum = 0u; cnt = 0u; mine = 0u;
#pragma unroll
    for (unsigned j = 0; j < 16; ++j) { const unsigned c = xb_ld(&bar[XB_XCNT(j)]); sum += c; cnt += (c > 0u) ? 1u : 0u; mine = (j == x) ? c : mine; }
    if (sum == G) break;
    __builtin_amdgcn_s_sleep(1);
    if ((++sp & 255u) == 0u) { if (xb_ld(&bar[XB_TMO])) break; if (sp > XB_SPIN_CAP) { atomicAdd(&bar[XB_TMO], 1u); break; } }
  }
  nloc = mine > 0u ? mine : 1u; nx = cnt > 0u ? cnt : 1u;
}
DEV void xcd_barrier(const XcdBarrier& b) {
  asm volatile("s_waitcnt vmcnt(0)" ::: "memory");
  __syncthreads();
  if (threadIdx.x == 0) {
    unsigned* bar = b.bar;
    __builtin_amdgcn_s_waitcnt(0);
    unsigned nloc = b.st[0], nx = b.st[1];
    if (nloc == 0u) { xcd_barrier_complete(bar, b.x, nloc, nx); b.st[0] = nloc; b.st[1] = nx; }
    const unsigned old = xb_add(&bar[XB_XSUB(b.x)], 1u);
    const unsigned gen = old / nloc;
    if (old + 1u == (gen + 1u) * nloc) {
      __builtin_amdgcn_fence(__ATOMIC_RELEASE, "agent");
      asm volatile("s_waitcnt vmcnt(0)" ::: "memory");
      const unsigned og = xb_add(&bar[XB_TOP], 1u);
      const unsigned tg = og / nx;
      if (og + 1u == (tg + 1u) * nx) xb_add(&bar[XB_TOPGEN], 1u);
      else XB_SPIN(xb_ld(&bar[XB_TOPGEN]) == tg, bar);
      __builtin_amdgcn_fence(__ATOMIC_ACQUIRE, "agent");
      xb_add(&bar[XB_XGEN(b.x)], 1u);
      asm volatile("s_waitcnt vmcnt(0)" ::: "memory");
    } else {
      XB_SPIN(xb_ld(&bar[XB_XGEN(b.x)]) == gen, bar);
      __builtin_amdgcn_fence(__ATOMIC_ACQUIRE, "agent");
      asm volatile("s_waitcnt vmcnt(0)" ::: "memory");
    }
  }
  __syncthreads();
}

DEV int next_item(unsigned* ctr, volatile int* sh) {
  __syncthreads();
  if (TIDX == 0) *sh = (int)__hip_atomic_fetch_add(ctr, 1u, __ATOMIC_RELAXED, __HIP_MEMORY_SCOPE_AGENT);
  __syncthreads();
  return __builtin_amdgcn_readfirstlane(*sh);
}
DEV bool xcd_tile(int q, int Mper, int Nt, int& m, int& n) {
  if (q >= Mper * Nt) return false;
  const int g = q / (8 * Nt), rem = q - g * 8 * Nt;
  const int gsz = (Mper - 8 * g) < 8 ? (Mper - 8 * g) : 8;
  n = rem / gsz; m = (blockIdx.x & 7) * Mper + 8 * g + rem % gsz;
  return true;
}
constexpr int NPHASE = 2 + 10 * 4;
DEV void run_phase(const Params& p, int ph, char* lds, volatile int* shq, int probe = 0) {
  const int G = gridDim.x, bid = blockIdx.x;
  if (ph == 0) {
    const int m1 = 384, m2 = m1 + 128, m3 = m2 + 1;
    const int n1 = m3 + CV_IN, n2 = n1 + CV_OUT, n3 = n2 + CV_UP, n4 = n3 + CV_DOWN, n5 = n4 + CV_C1, n6 = n5 + CV_C2;
    for (int it = bid; it < n6; it += G) {
      if (it < m1) mod_item(p, it, lds);
      else if (it < m2) pebias_item(p, it - m1, lds);
      else if (it < m3) lut_item(p);
      else if (it < n1) cvt_in_item(p, 0, it - m3, lds);
      else if (it < n2) cvt_out_item(p, 0, it - n1, lds);
      else if (it < n3) cvt_up_item(p, 0, it - n2, lds);
      else if (it < n4) cvt_down_item(p, 0, it - n3, lds);
      else if (it < n5) cvt_c1_item(p, 0, it - n4, lds);
      else cvt_c2_item(p, 0, it - n5, lds);
    }
    return;
  }
  if (ph == 1) {
    if (bid == 0) pebias_final(p);
    norm_rows(nullptr, nullptr, nullptr, p.x, nullptr, p.norm_g + 0, p.mod + 1 * 1024, p.mod + 0 * 1024, p.H);
    return;
  }
  const int l = (ph - 2) / 10, sp = (ph - 2) % 10;
  const float* modl = p.mod + (size_t)l * 8 * 6144;
  const float* ng = p.norm_g + (size_t)l * 4 * 1024;
  switch (sp) {
    case 0: { int m, n; for (int q = bid >> 3; xcd_tile(q, 32, 26, m, n); q += G >> 3) gemm_in_item(p, m * 26 + n, lds); } break;
    case 1: {
      const int n1 = 64, n2 = n1 + 512, n3 = n2 + 48, n4 = n3 + (l < 3 ? CV_IN : 0);
      for (;;) {
        const int it = next_item(p.bar + ph + probe * 64, shq);
        if (it >= n4) break;
        if (it < n1) { gemm_c1_item(p, l, it, lds); __syncthreads(); gemm_c2_item(p, it, lds); }
        else if (it < n2) rwkv_prep_item(p, l, it - n1, lds);
        else if (it < n3) fox_cum_item(p, l, it - n2, lds);
        else cvt_in_item(p, l + 1, it - n3, lds);
      }
    } break;
    case 2: break;
    case 3: {
      const int n1 = 128, n2 = n1 + FOX_ITEMS, n3 = n2 + 1024, n3b = n3 + (l < 3 ? CV_C1 + CV_C2 : 0);
      const int n4 = n3b + (l > 0 ? CV_OUT + CV_UP + CV_DOWN : 0);
      if (bid < n1) scan_item(p, bid, lds);
      for (;;) {
        const int it = n1 + next_item(p.bar + ph + probe * 64, shq);
        if (it >= n4) break;
        if (it < n2) fox_item(p, it - n1, lds);
        else if (it < n3) nsa_cmp_item(p, it - n2, lds);
        else if (it < n3b) { if (it < n3 + CV_C1) cvt_c1_item(p, l + 1, it - n3, lds); else cvt_c2_item(p, l + 1, it - n3 - CV_C1, lds); }
        else if (it < n3b + CV_OUT) cvt_out_item(p, l, it - n3b, lds);
        else if (it < n3b + CV_OUT + CV_UP) cvt_up_item(p, l, it - n3b - CV_OUT, lds);
        else cvt_down_item(p, l, it - n3b - CV_OUT - CV_UP, lds);
      }
    } break;
    case 4: {
      const int n1 = 1024, n2 = n1 + 512;
      for (;;) {
        const int it = next_item(p.bar + ph + probe * 64, shq);
        if (it >= n2) break;
        if (it < n1) nsa_sw_item(p, ((it & 15) << 6) | (it >> 4), lds);
        else rwkv_post_item(p, l, it - n1);
      }
    } break;
    case 5: { int m, n; for (int q = bid >> 3; xcd_tile(q, 32, 8, m, n); q += G >> 3) gemm_f32_item(p, p.H, D, p.Wt_out, (bf16_t*)p.ybuf, m * 8 + n, lds); } break;
    case 6: {
      norm_rows((const bf16_t*)p.ybuf, ng + 1024, modl + 2 * 1024, l == 0 ? p.x : p.xo, p.xo, ng + 2 * 1024, modl + 4 * 1024, modl + 3 * 1024, p.H);
    } break;
    case 7: { int m, n; for (int q = bid >> 3; xcd_tile(q, 33, 44, m, n); q += G >> 3) gemm_up_item(p, l, m * 44 + n, lds); } break;
    case 8: { int m, n; for (int q = bid >> 3; xcd_tile(q, 32, 8, m, n); q += G >> 3) gemm_f32_item(p, p.act, DFF, p.Wt_down, (bf16_t*)p.ybuf, m * 8 + n, lds); } break;
    case 9: {
      if (l < 3) {
        const float* modn = p.mod + (size_t)(l + 1) * 8 * 6144;
        norm_rows((const bf16_t*)p.ybuf, ng + 3 * 1024, modl + 5 * 1024, p.xo, p.xo, p.norm_g + (size_t)(l + 1) * 4 * 1024, modn + 1 * 1024, modn + 0 * 1024, p.H);
      } else {
        norm_rows((const bf16_t*)p.ybuf, ng + 3 * 1024, modl + 5 * 1024, p.xo, p.xo, nullptr, nullptr, nullptr, nullptr);
      }
    } break;
  }
}

__global__ void __launch_bounds__(256, 2) fwd_kernel(Params p) {
  __shared__ __attribute__((aligned(16))) char lds[LDSB];
  __shared__ uint4 xb_words;
  __shared__ int shq;
  if (threadIdx.x == 0) xb_words = make_uint4(0u, 0u, 0u, 0u);
  __syncthreads();
  XcdBarrier xb = xcd_barrier_post(p.bar, (volatile LAS unsigned*)&xb_words);
  for (int ph = p.ph0; ph < p.ph1; ++ph) {
    if (ph >= 2 && (ph - 2) % 10 == 2) continue;
    run_phase(p, ph, lds, &shq);
#ifdef DUP_SP
    if (ph >= 2 && (ph - 2) % 10 == DUP_SP) { xcd_barrier(xb); run_phase(p, ph, lds, &shq, 1); }
#endif
    if (ph + 1 < p.ph1) { if (p.ph1 > NPHASE) cg::this_grid().sync(); else xcd_barrier(xb); }
  }
}

#ifdef DBG_NPH
__global__ void dbg_dump(Params p, int which) {
  size_t i = (size_t)blockIdx.x * 256 + threadIdx.x;
  float v;
  if (which == 0) v = bf2f(p.H[i]);
  else if (which == 1) v = bf2f(p.P16[i]);
  else if (which == 2) v = p.P32[i];
  else if (which == 3) v = bf2f(p.SC[i]);
  else if (which == 4) v = bf2f(p.VtF[i % ((size_t)48 * 64 * S)]);
  else if (which == 6) v = bf2f(p.Wt_in[i % ((size_t)NINP * D)]);
  else if (which == 7) v = p.mod[i % ((size_t)4 * 8 * 6144)];
  else v = (float)(p.selmask[i % ((size_t)16 * S)] % 1000003ull);
  p.xo[i] = v;
}
#endif
extern "C" void kernel_launch(void* const* d_in, const int* in_sizes, int n_in, void* d_out, int out_size, void* d_ws, size_t ws_size, hipStream_t stream) {
  Params p{};
  const float** ins = (const float**)&p.x;
  for (int i = 0; i < 30; ++i) ins[i] = (const float*)d_in[i];
  p.xo = (float*)d_out;
  char* w = (char*)d_ws; size_t off = 0;
  auto take = [&](size_t bytes) __attribute__((always_inline)) { char* r = w + off; off += (bytes + 255) & ~(size_t)255; return r; };
  p.bar = (unsigned*)take(65536);
  p.Wt_in = (bf16_t*)take((size_t)NINP * D * 2);
  p.Wt_out = (bf16_t*)take((size_t)D * D * 2);
  p.Wt_up = (bf16_t*)take((size_t)2 * DFF * D * 2);
  p.Wt_down = (bf16_t*)take((size_t)D * DFF * 2);
  p.Wc1 = (bf16_t*)take((size_t)2 * 128 * 2048 * 2);
  p.Wc2 = (bf16_t*)take((size_t)2 * 128 * 128 * 2);
  p.mod = (float*)take((size_t)4 * 8 * 6144 * 4);
  p.pebias = (float*)take(8 * 128 * 4);
  p.pepart = (float*)take(128 * 128 * 4);
  p.lut = (float*)take(6 * 128 * 4);
  p.kbias = (float*)take((size_t)48 * S * 4);
  p.BS = (float*)take((size_t)T * 4 * 4);
  p.selmask = (u64*)take((size_t)16 * S * 8);
  p.Hc = (bf16_t*)take((size_t)2 * 4096 * 128 * 2);
  p.Kc = (bf16_t*)take((size_t)16 * 256 * 64 * 2);
  p.VtC = (bf16_t*)take((size_t)16 * 64 * 256 * 2);
  p.H = (bf16_t*)take((size_t)T * D * 2);
  char* ra = take((size_t)T * D * 4);
  p.Prkv = (bf16_t*)(ra + (size_t)T * 128 * 4);
  p.P32 = (float*)ra; p.ybuf = (float*)ra; p.yscan = (float*)ra; p.ocmp = (bf16_t*)(ra + (size_t)T * 256 * 4); p.oslc = (bf16_t*)(ra + (size_t)T * 640 * 4);
  char* rb = w + off;
  p.act = (bf16_t*)rb;
  p.P16 = (bf16_t*)take((size_t)T * LDP16 * 2);
  p.VtF = (bf16_t*)take((size_t)48 * 64 * S * 2);
  p.VtS = (bf16_t*)take((size_t)16 * 64 * S * 2);
  p.VtW = (bf16_t*)take((size_t)16 * 64 * S * 2);
  p.PG = (float*)take((size_t)T * 32 * 4);
  p.SC = (bf16_t*)take((size_t)T * 4 * 320 * 2);
  p.SV = (bf16_t*)take((size_t)T * 256 * 2);
  p.SG = (bf16_t*)take((size_t)T * 256 * 2);
  if (off > ws_size) fprintf(stderr, "workspace too small: need %zu have %zu\n", off, ws_size);
  static int grid_blocks = 0;
  if (!grid_blocks) {
    int dev = 0, cus = 0, per_cu = 0;
    hipGetDevice(&dev);
    hipDeviceGetAttribute(&cus, hipDeviceAttributeMultiprocessorCount, dev);
    hipOccupancyMaxActiveBlocksPerMultiprocessor(&per_cu, fwd_kernel, 256, 0);
    if (per_cu > 2) per_cu = 2;
    if (per_cu < 1) per_cu = 1;
    grid_blocks = cus * per_cu;
  }
#if SINGLE_LAUNCH
  p.ph0 = 0; p.ph1 = NPHASE;
  hipMemsetAsync(p.bar, 0, XCD_BAR_WORDS * 4, stream);
  void* args[] = {&p};
  hipError_t e = hipLaunchCooperativeKernel((void*)fwd_kernel, dim3(grid_blocks), dim3(256), args, 0, stream);
  if (e != hipSuccess) fprintf(stderr, "cooperative launch failed: %s (grid %d)\n", hipGetErrorString(e), grid_blocks);
#else
#ifdef DBG_NPH
  for (int ph = 0; ph < DBG_NPH; ++ph) {
    p.ph0 = ph; p.ph1 = ph + 1;
    hipLaunchKernelGGL(fwd_kernel, dim3(grid_blocks), dim3(256), 0, stream, p);
  }
  hipLaunchKernelGGL(dbg_dump, dim3(T * D / 256), dim3(256), 0, stream, p, DBG_BUF);
#else
  for (int ph = 0; ph < NPHASE; ++ph) {
    p.ph0 = ph; p.ph1 = ph + 1;
    hipLaunchKernelGGL(fwd_kernel, dim3(grid_blocks), dim3(256), 0, stream, p);
  }
#endif
#endif
}
```

```cpp
#include <hip/hip_runtime.h>
#include <hip/hip_cooperative_groups.h>
#include <stdint.h>
#include <cstdio>
namespace cg = cooperative_groups;

#ifndef SINGLE_LAUNCH
#define SINGLE_LAUNCH 1
#endif

#define DEV __device__ __forceinline__
typedef unsigned short bf16_t;
typedef short bf16x8 __attribute__((ext_vector_type(8)));
typedef short bf16x4 __attribute__((ext_vector_type(4)));
typedef float f32x4 __attribute__((ext_vector_type(4)));
typedef unsigned u32x4 __attribute__((ext_vector_type(4)));
typedef unsigned u32x2 __attribute__((ext_vector_type(2)));
typedef unsigned long long u64;

constexpr int S = 4096, T = 32768, D = 1024;
constexpr int NIN = 3224, NINP = 3328;
constexpr int LDP16 = 1664;
constexpr int C_FQ = 0, C_FK = 384, C_NQ = 768, C_KC = 1152, C_VC = 1280, C_KS = 1408, C_KW = 1536;
constexpr int DFF = 2816;
constexpr int LDSB = 2 * 18432 + 512 + 32768;
constexpr float LOG2E = 1.4426950408889634f;
constexpr float QSCALE = 0.125f * LOG2E;
constexpr float NEGM = -1e30f;
constexpr float MINIT = -1e20f;

struct Params {
  const float *x, *c, *ada_w, *ada_b, *norm_g, *w_in, *mu, *w0, *w_up, *a0, *a_up, *g_up, *k_k, *k_a, *r_k, *ln_w, *ln_b,
      *b_f, *pe_k, *pe_v, *ck_w1, *ck_w2, *cv_w1, *cv_w2, *rel_bias, *w_out, *ffn_up, *conv_w, *conv_b, *ffn_down;
  float* xo;
  unsigned* bar;
  bf16_t *Wt_in, *Wt_out, *Wt_up, *Wt_down, *Wc1, *Wc2;
  float *mod, *pebias, *pepart, *lut, *kbias, *BS;
  u64* selmask;
  bf16_t *Hc, *Kc, *VtC;
  bf16_t* H;
  float *P32, *ybuf, *yscan; bf16_t *ocmp, *oslc;
  bf16_t* Prkv;
  bf16_t *P16, *VtF, *VtS, *VtW;
  float* PG;
  bf16_t *SC, *SV, *SG;
  bf16_t* act;
  int ph0, ph1;
};

DEV int opq_tid() { int v = threadIdx.x; asm volatile("" : "+v"(v)); return v; }
#define TIDX opq_tid()
typedef float f32x2 __attribute__((ext_vector_type(2)));
typedef __bf16 bf16x2v __attribute__((ext_vector_type(2)));
DEV unsigned cvt_pk_bf16(float lo, float hi) { f32x2 v = {lo, hi}; bf16x2v r = __builtin_convertvector(v, bf16x2v); return __builtin_bit_cast(unsigned, r); }
DEV bf16_t f2bf(float f) { return (bf16_t)(cvt_pk_bf16(f, 0.f) & 0xffffu); }
DEV float bf2f(bf16_t v) { return __uint_as_float(((unsigned)v) << 16); }
DEV float fexp2(float x) { return __builtin_amdgcn_exp2f(x); }
DEV float frcp(float x) { return __builtin_amdgcn_rcpf(x); }
DEV float fsigmoid(float x) { return frcp(1.f + __expf(-x)); }
DEV float fsoftplus(float x) { return fmaxf(x, 0.f) + __logf(1.f + __expf(-fabsf(x))); }
DEV float dpp_sum16(float x) {
  int v;
  v = __builtin_amdgcn_mov_dpp(__float_as_int(x), 0xB1, 0xF, 0xF, true); x += __int_as_float(v);
  v = __builtin_amdgcn_mov_dpp(__float_as_int(x), 0x4E, 0xF, 0xF, true); x += __int_as_float(v);
  v = __builtin_amdgcn_mov_dpp(__float_as_int(x), 0x124, 0xF, 0xF, true); x += __int_as_float(v);
  v = __builtin_amdgcn_mov_dpp(__float_as_int(x), 0x128, 0xF, 0xF, true); x += __int_as_float(v);
  return x;
}
DEV float wave_sum(float v) {
  v = dpp_sum16(v);
  const float a = __int_as_float(__builtin_amdgcn_readlane(__float_as_int(v), 0)), b = __int_as_float(__builtin_amdgcn_readlane(__float_as_int(v), 16));
  const float c = __int_as_float(__builtin_amdgcn_readlane(__float_as_int(v), 32)), d = __int_as_float(__builtin_amdgcn_readlane(__float_as_int(v), 48));
  return (a + b) + (c + d);
}
DEV int t5_bucket(int n) {
  if (n < 0) n = 0;
  if (n < 16) return n;
  float nf = (float)n;
  int large = 16 + (int)(logf(nf / 16.f) / 2.0794415416798357f * 16.f);
  return large < 31 ? large : 31;
}

template <class Map>
DEV void cvt_tile(const float* src, int lds_ld, bf16_t* dst, int Kd, int n0, int k0, Map map, char* lds) {
  float* sm = (float*)lds;
  const int tid = TIDX, tx = tid & 63, ty = tid >> 6;
  const int sc = map(n0 + tx);
  __syncthreads();
  float tv[16];
#pragma unroll
  for (int i = 0; i < 16; ++i) tv[i] = sc >= 0 ? src[(size_t)(k0 + ty + 4 * i) * lds_ld + sc] : 0.f;
#pragma unroll
  for (int i = 0; i < 16; ++i) sm[(ty + 4 * i) * 65 + tx] = tv[i];
  __syncthreads();
#pragma unroll
  for (int i = 0; i < 16; ++i) {
    int nn = ty + 4 * i;
    dst[(size_t)(n0 + nn) * Kd + k0 + tx] = f2bf(sm[tx * 65 + nn]);
  }
}
DEV int map_in(int n) { return n < 2048 ? n : (n < 3200 ? 2054 + (n - 2048) : (n < 3206 ? 2048 + (n - 3200) : (n < 3224 ? n : -1))); }
DEV int map_up(int n) { int j = n >> 7, c = n & 127; return c < 64 ? 64 * j + c : DFF + 64 * j + (c - 64); }

constexpr int CV_IN = 52 * 16, CV_OUT = 16 * 16, CV_UP = 88 * 16, CV_DOWN = 16 * 44, CV_C1 = 2 * 2 * 32, CV_C2 = 2 * 2 * 2;
DEV void cvt_in_item(const Params& p, int l, int it, char* lds) {
  int nt = it / 16, kt = it % 16;
  cvt_tile(p.w_in + (size_t)l * D * NIN, NIN, p.Wt_in, D, nt * 64, kt * 64, [](int n) __attribute__((always_inline)) { return map_in(n); }, lds);
}
DEV void cvt_out_item(const Params& p, int l, int it, char* lds) {
  int nt = it / 16, kt = it % 16;
  cvt_tile(p.w_out + (size_t)l * D * D, D, p.Wt_out, D, nt * 64, kt * 64, [](int n) __attribute__((always_inline)) { return n; }, lds);
}
DEV void cvt_up_item(const Params& p, int l, int it, char* lds) {
  int nt = it / 16, kt = it % 16;
  cvt_tile(p.ffn_up + (size_t)l * D * 2 * DFF, 2 * DFF, p.Wt_up, D, nt * 64, kt * 64, [](int n) __attribute__((always_inline)) { return map_up(n); }, lds);
}
DEV void cvt_down_item(const Params& p, int l, int it, char* lds) {
  int nt = it / 44, kt = it % 44;
  cvt_tile(p.ffn_down + (size_t)l * DFF * D, D, p.Wt_down, DFF, nt * 64, kt * 64, [](int n) __attribute__((always_inline)) { return n; }, lds);
}
DEV void cvt_c1_item(const Params& p, int l, int it, char* lds) {
  int kv = it / 64, r = it % 64, nt = r / 32, kt = r % 32;
  const float* src = (kv ? p.cv_w1 : p.ck_w1) + (size_t)l * 2048 * 128;
  cvt_tile(src, 128, p.Wc1 + (size_t)kv * 128 * 2048, 2048, nt * 64, kt * 64, [](int n) __attribute__((always_inline)) { return n; }, lds);
}
DEV void cvt_c2_item(const Params& p, int l, int it, char* lds) {
  int kv = it / 4, r = it % 4, nt = r / 2, kt = r % 2;
  const float* src = (kv ? p.cv_w2 : p.ck_w2) + (size_t)l * 128 * 64;
  cvt_tile(src, 64, p.Wc2 + (size_t)kv * 128 * 128, 128, nt * 64, kt * 64, [](int n) __attribute__((always_inline)) { return n < 64 ? n : -1; }, lds);
}

DEV void mod_item(const Params& p, int it, char* lds) {
  float* sc = (float*)lds;
  float* red = sc + 8192;
  const int tid = TIDX, cx = tid & 63, kq = tid >> 6;
  const int l = it / 96, n = (it % 96) * 64 + cx;
  __syncthreads();
  for (int i = tid; i < 8192; i += 256) { float v = p.c[i]; sc[i] = v / (1.f + __expf(-v)); }
  __syncthreads();
  float acc[8];
#pragma unroll
  for (int b = 0; b < 8; ++b) acc[b] = 0.f;
  const float* w = p.ada_w + (size_t)l * D * 6144 + n;
#pragma unroll 32
  for (int k = kq * 256; k < kq * 256 + 256; ++k) {
    float wv = w[(size_t)k * 6144];
#pragma unroll
    for (int b = 0; b < 8; ++b) acc[b] += sc[b * 1024 + k] * wv;
  }
#pragma unroll
  for (int b = 0; b < 8; ++b) red[(kq * 8 + b) * 64 + cx] = acc[b];
  __syncthreads();
  if (kq == 0) {
#pragma unroll
    for (int b = 0; b < 8; ++b) {
      float v = red[b * 64 + cx] + red[(8 + b) * 64 + cx] + red[(16 + b) * 64 + cx] + red[(24 + b) * 64 + cx];
      p.mod[((size_t)l * 8 + b) * 6144 + n] = v + p.ada_b[(size_t)l * 6144 + n];
    }
  }
}
DEV void pebias_item(const Params& p, int it, char* lds) {
  float* red = (float*)lds;
  const int tid = TIDX, n = tid & 127, hf = tid >> 7;
  const int lk = it >> 4, kc = it & 15, l = lk >> 1, kv = lk & 1;
  const float* pe = (kv ? p.pe_v : p.pe_k) + (size_t)l * 2048;
  const float* w = (kv ? p.cv_w1 : p.ck_w1) + (size_t)l * 2048 * 128;
  float acc = 0.f;
  const int k0 = kc * 128 + hf * 64;
#pragma unroll 16
  for (int k = k0; k < k0 + 64; ++k) acc += pe[k] * w[(size_t)k * 128 + n];
  __syncthreads();
  red[tid] = acc;
  __syncthreads();
  if (hf == 0) p.pepart[(size_t)it * 128 + n] = red[n] + red[128 + n];
}
DEV void pebias_final(const Params& p) {
  const int tid = TIDX;
  for (int o = tid; o < 8 * 128; o += 256) {
    const int lk = o >> 7, n = o & 127; float a = 0.f;
#pragma unroll
    for (int kc = 0; kc < 16; ++kc) a += p.pepart[(size_t)(lk * 16 + kc) * 128 + n];
    p.pebias[o] = a;
  }
}
DEV void lut_item(const Params& p) {
  const int tid = TIDX;
  if (tid < 128) {
    int bk = t5_bucket(tid);
#pragma unroll
    for (int h = 0; h < 6; ++h) p.lut[h * 128 + tid] = p.rel_bias[bk * 6 + h] * LOG2E;
  }
}

DEV void norm_rows(const bf16_t* y, const float* gy, const float* modgate  ,
                   const float* xin, float* xout, const float* gh, const float* modsc, const float* modsh, bf16_t* hout) {
  const int lane = TIDX & 63, wid = TIDX >> 6;
  const int nw = gridDim.x * 4;
  constexpr int U = 2;
  for (int row0 = blockIdx.x * 4 + wid; row0 < T; row0 += U * nw) {
    f32x4 xv[U][4], yv[U][4];
#pragma unroll
    for (int u = 0; u < U; ++u) {
      const int row = row0 + u * nw;
#pragma unroll
      for (int i = 0; i < 4; ++i) xv[u][i] = *(const f32x4*)(xin + (size_t)row * D + i * 256 + lane * 4);
      if (y) {
#pragma unroll
        for (int i = 0; i < 4; ++i) { u32x2 w = *(const u32x2*)(y + (size_t)row * D + i * 256 + lane * 4);
          yv[u][i] = (f32x4){__uint_as_float(w.x << 16), __uint_as_float(w.x & 0xffff0000u), __uint_as_float(w.y << 16), __uint_as_float(w.y & 0xffff0000u)}; }
      }
    }
#pragma unroll
    for (int u = 0; u < U; ++u) {
      const int row = row0 + u * nw; const int b = row >> 12;
      if (y) {
        float ss = 0.f;
#pragma unroll
        for (int i = 0; i < 4; ++i) ss += yv[u][i][0] * yv[u][i][0] + yv[u][i][1] * yv[u][i][1] + yv[u][i][2] * yv[u][i][2] + yv[u][i][3] * yv[u][i][3];
        ss = wave_sum(ss);
        const float rs = rsqrtf(ss * (1.f / 1024.f) + 1e-6f);
#pragma unroll
        for (int i = 0; i < 4; ++i) {
          f32x4 g = *(const f32x4*)(gy + i * 256 + lane * 4);
          f32x4 mg = *(const f32x4*)(modgate + (size_t)b * 6144 + i * 256 + lane * 4);
          xv[u][i] = xv[u][i] + mg * (yv[u][i] * rs * g);
        }
      }
      if (xout) {
#pragma unroll
        for (int i = 0; i < 4; ++i) *(f32x4*)(xout + (size_t)row * D + i * 256 + lane * 4) = xv[u][i];
      }
      if (hout) {
        float ss = 0.f;
#pragma unroll
        for (int i = 0; i < 4; ++i) ss += xv[u][i][0] * xv[u][i][0] + xv[u][i][1] * xv[u][i][1] + xv[u][i][2] * xv[u][i][2] + xv[u][i][3] * xv[u][i][3];
        ss = wave_sum(ss);
        const float rs = rsqrtf(ss * (1.f / 1024.f) + 1e-6f);
#pragma unroll
        for (int i = 0; i < 4; ++i) {
          f32x4 g = *(const f32x4*)(gh + i * 256 + lane * 4);
          f32x4 sc = *(const f32x4*)(modsc + (size_t)b * 6144 + i * 256 + lane * 4);
          f32x4 sh = *(const f32x4*)(modsh + (size_t)b * 6144 + i * 256 + lane * 4);
          f32x4 hv = (xv[u][i] * rs * g) * (sc + 1.f) + sh;
          u32x2 w; w.x = cvt_pk_bf16(hv[0], hv[1]); w.y = cvt_pk_bf16(hv[2], hv[3]);
          *(u32x2*)(hout + (size_t)row * D + i * 256 + lane * 4) = w;
        }
      }
    }
  }
}

constexpr int LS = 72;
DEV void glds16(const void* gsrc, unsigned lds_dst) {
  unsigned keep;
  asm volatile("s_mov_b32 %0, m0\n\ts_mov_b32 m0, %2\n\ts_nop 0\n\tglobal_load_lds_dwordx4 %1, off\n\ts_mov_b32 m0, %0" : "=&s"(keep) : "v"(gsrc), "s"(lds_dst) : "memory");
}
DEV int grow(int tid) { return (tid >> 6) * 32 + ((tid & 63) >> 3); }
DEV int gchunk(int tid) { return (tid & 7) ^ ((tid & 63) >> 3); }
template <bool SWAP, class Epi>
DEV void gemm128(const bf16_t* (&ab)[4], long akstep, const bf16_t* (&bb)[4], long bkstep, int nk, char* lds, Epi&& epi) {
  const int tid = TIDX, lane = tid & 63, wid = __builtin_amdgcn_readfirstlane(tid >> 6), wm = wid >> 1, wn = wid & 1, fr = lane & 15, fq = lane >> 4;
  const unsigned lbase = (unsigned)(size_t)((__attribute__((address_space(3))) char*)lds) + (unsigned)wid * 4096u;
  const int ra0 = (wm * 64 + fr) * 128, rb0 = 16384 + (wn * 64 + fr) * 128;
  const int sw0 = ((fq) ^ (fr & 7)) << 4, sw1 = ((4 + fq) ^ (fr & 7)) << 4;
  f32x4 acc[4][4];
#pragma unroll
  for (int m = 0; m < 4; ++m)
#pragma unroll
    for (int n = 0; n < 4; ++n) acc[m][n] = (f32x4){0.f, 0.f, 0.f, 0.f};
  auto issue = [&](int t) __attribute__((always_inline)) {
    const unsigned st = lbase + (unsigned)(t & 1) * 32768u;
#pragma unroll
    for (int i = 0; i < 4; ++i) { glds16(ab[i] + (long)t * akstep, st + i * 1024u); glds16(bb[i] + (long)t * bkstep, st + 16384u + i * 1024u); }
  };
  __syncthreads();
  issue(0);
  if (nk > 1) issue(1);
  for (int kt = 0; kt < nk; ++kt) {
    if (kt + 1 < nk) asm volatile("s_waitcnt vmcnt(8)" ::: "memory"); else asm volatile("s_waitcnt vmcnt(0)" ::: "memory");
    __builtin_amdgcn_s_barrier();
    asm volatile("" ::: "memory");
    const char* cur = lds + (kt & 1) * 32768;
#pragma unroll
    for (int ks = 0; ks < 2; ++ks) {
      const int sw = ks ? sw1 : sw0;
      bf16x8 af[4], bfr[4];
#pragma unroll
      for (int m = 0; m < 4; ++m) af[m] = *(const bf16x8*)(cur + ra0 + m * 2048 + sw);
#pragma unroll
      for (int n = 0; n < 4; ++n) bfr[n] = *(const bf16x8*)(cur + rb0 + n * 2048 + sw);
#pragma unroll
      for (int m = 0; m < 4; ++m)
#pragma unroll
        for (int n = 0; n < 4; ++n)
          acc[m][n] = SWAP ? __builtin_amdgcn_mfma_f32_16x16x32_bf16(bfr[n], af[m], acc[m][n], 0, 0, 0)
                           : __builtin_amdgcn_mfma_f32_16x16x32_bf16(af[m], bfr[n], acc[m][n], 0, 0, 0);
    }
    asm volatile("s_waitcnt lgkmcnt(0)" ::: "memory");
    __builtin_amdgcn_s_barrier();
    asm volatile("" ::: "memory");
    if (kt + 2 < nk) issue(kt + 2);
  }
  epi(acc, wm, wn, fr, fq);
}

DEV void gemm_in_item(const Params& p, int item, char* lds) {
  const int mt = item / 26, j = item % 26;
  const int tid = TIDX, lrow = grow(tid), lkc = gchunk(tid);
  const bf16_t* ab[4]; const bf16_t* bb[4];
#pragma unroll
  for (int i = 0; i < 4; ++i) {
    ab[i] = p.H + (size_t)(mt * 128 + lrow + 8 * i) * D + lkc * 8;
    bb[i] = p.Wt_in + (size_t)(j * 128 + lrow + 8 * i) * D + lkc * 8;
  }
  const int row0 = mt * 128;
  const bool vt = (j >= 13 && j <= 15) || j == 22 || j == 24;
  if (vt) {
    bf16_t* base; int nh;
    int hc0;
    if (j <= 15) { base = p.VtF; nh = 6; hc0 = (j - 13) * 128; } else if (j == 22) { base = p.VtS; nh = 2; hc0 = 0; } else { base = p.VtW; nh = 2; hc0 = 0; }
    gemm128<false>(ab, 64, bb, 64, 16, lds, [&](f32x4 (&acc)[4][4], int wm, int wn, int fr, int fq) {
#pragma unroll
      for (int m = 0; m < 4; ++m)
#pragma unroll
        for (int n = 0; n < 4; ++n) {
          int tok = row0 + wm * 64 + m * 16 + fq * 4; int b = tok >> 12, s = tok & 4095;
          int hc = hc0 + wn * 64 + n * 16 + fr; int hd = hc >> 6, d = hc & 63;
          u32x2 w; w.x = cvt_pk_bf16(acc[m][n][0], acc[m][n][1]); w.y = cvt_pk_bf16(acc[m][n][2], acc[m][n][3]);
          *(u32x2*)(base + ((size_t)(b * nh + hd) * 64 + d) * S + s) = w;
        }
    });
  } else if (j == 6 || j == 25) {
    float* base; int ld, c0, cmax;
    if (j == 6) { base = p.P32; ld = 128; c0 = 0; cmax = 128; } else { base = p.PG; ld = 32; c0 = 0; cmax = 32; }
    gemm128<true>(ab, 64, bb, 64, 16, lds, [&](f32x4 (&acc)[4][4], int wm, int wn, int fr, int fq) {
#pragma unroll
      for (int m = 0; m < 4; ++m)
#pragma unroll
        for (int n = 0; n < 4; ++n) {
          int tok = row0 + wm * 64 + m * 16 + fr; int col = c0 + wn * 64 + n * 16 + fq * 4;
          if (col < cmax) *(f32x4*)(base + (size_t)tok * ld + col) = acc[m][n];
        }
    });
  } else {
    int c0; bf16_t* ob = p.P16; int old_ = LDP16;
    if (j < 6) { ob = p.Prkv; old_ = 768; c0 = j * 128; }
    else if (j <= 12) c0 = (j - 7) * 128;
    else if (j <= 18) c0 = C_NQ + (j - 16) * 128;
    else if (j == 19) c0 = C_KC; else if (j == 20) c0 = C_VC; else if (j == 21) c0 = C_KS; else c0 = C_KW;
    const float qs = ((j >= 7 && j <= 9) || (j >= 16 && j <= 18)) ? QSCALE : 1.f;
    gemm128<true>(ab, 64, bb, 64, 16, lds, [&](f32x4 (&acc)[4][4], int wm, int wn, int fr, int fq) {
#pragma unroll
      for (int m = 0; m < 4; ++m)
#pragma unroll
        for (int n = 0; n < 4; ++n) {
          int tok = row0 + wm * 64 + m * 16 + fr; int col = c0 + wn * 64 + n * 16 + fq * 4;
          u32x2 w; w.x = cvt_pk_bf16(acc[m][n][0] * qs, acc[m][n][1] * qs); w.y = cvt_pk_bf16(acc[m][n][2] * qs, acc[m][n][3] * qs);
          *(u32x2*)(ob + (size_t)tok * old_ + col) = w;
        }
    });
  }
}
DEV void gemm_f32_item(const Params& p, const bf16_t* A, int K, const bf16_t* Bt, bf16_t* out, int item, char* lds) {
  const int mt = item >> 3, nt = item & 7;
  const int tid = TIDX, lrow = grow(tid), lkc = gchunk(tid);
  const bf16_t* ab[4]; const bf16_t* bb[4];
#pragma unroll
  for (int i = 0; i < 4; ++i) {
    ab[i] = A + (size_t)(mt * 128 + lrow + 8 * i) * K + lkc * 8;
    bb[i] = Bt + (size_t)(nt * 128 + lrow + 8 * i) * K + lkc * 8;
  }
  gemm128<true>(ab, 64, bb, 64, K / 64, lds, [&](f32x4 (&acc)[4][4], int wm, int wn, int fr, int fq) {
#pragma unroll
    for (int m = 0; m < 4; ++m)
#pragma unroll
      for (int n = 0; n < 4; ++n) {
        int tok = mt * 128 + wm * 64 + m * 16 + fr; int col = nt * 128 + wn * 64 + n * 16 + fq * 4;
        u32x2 w; w.x = cvt_pk_bf16(acc[m][n][0], acc[m][n][1]); w.y = cvt_pk_bf16(acc[m][n][2], acc[m][n][3]);
        *(u32x2*)(out + (size_t)tok * D + col) = w;
      }
  });
}
DEV void gemm_up_item(const Params& p, int l, int item, char* lds) {
  const int mtile = item / 44, j = item % 44;
  const int b = mtile / 33, i33 = mtile % 33;
  const int pos0 = 126 * i33 - 2;
  const int tid = TIDX, lrow = grow(tid), lkc = gchunk(tid);
  const bf16_t* ab[4]; const bf16_t* bb[4];
#pragma unroll
  for (int i = 0; i < 4; ++i) {
    int pos = pos0 + lrow + 8 * i; pos = pos < 0 ? 0 : (pos > S - 1 ? S - 1 : pos);
    ab[i] = p.H + (size_t)(b * S + pos) * D + lkc * 8;
    bb[i] = p.Wt_up + (size_t)(j * 128 + lrow + 8 * i) * D + lkc * 8;
  }
  float* su = (float*)lds;
  gemm128<true>(ab, 64, bb, 64, 16, lds, [&](f32x4 (&acc)[4][4], int wm, int wn, int fr, int fq) {
    __syncthreads();
#pragma unroll
    for (int m = 0; m < 4; ++m)
#pragma unroll
      for (int n = 0; n < 4; ++n) {
        int r = wm * 64 + m * 16 + fr; int col = wn * 64 + n * 16 + fq * 4;
        *(f32x4*)(su + r * 132 + col) = acc[m][n];
      }
  });
  __syncthreads();
  const int c = tid & 63, rg = tid >> 6;
  const float* cw = p.conv_w + (size_t)l * 3 * 2 * DFF; const float* cb = p.conv_b + (size_t)l * 2 * DFF;
  const int gc = 64 * j + c, vc = DFF + 64 * j + c;
  const float g0 = cw[gc], g1 = cw[2 * DFF + gc], g2 = cw[4 * DFF + gc], gb = cb[gc];
  const float v0 = cw[vc], v1 = cw[2 * DFF + vc], v2 = cw[4 * DFF + vc], vb = cb[vc];
  {
    const int r0 = 2 + rg * 32, r1 = (r0 + 32) < 128 ? (r0 + 32) : 128;
    float ug0 = (pos0 + r0 - 2 >= 0) ? su[(r0 - 2) * 132 + c] : 0.f, uv0 = (pos0 + r0 - 2 >= 0) ? su[(r0 - 2) * 132 + 64 + c] : 0.f;
    float ug1 = (pos0 + r0 - 1 >= 0) ? su[(r0 - 1) * 132 + c] : 0.f, uv1 = (pos0 + r0 - 1 >= 0) ? su[(r0 - 1) * 132 + 64 + c] : 0.f;
    bf16_t* op = p.act + (size_t)(b * S + pos0 + r0) * DFF + 64 * j + c;
    const int rend = (S - pos0) < r1 ? (S - pos0) : r1;
#pragma unroll 4
    for (int r = r0; r < rend; ++r) {
      const float ug2 = su[r * 132 + c], uv2 = su[r * 132 + 64 + c];
      const float g = gb + g0 * ug0 + g1 * ug1 + g2 * ug2;
      const float v = vb + v0 * uv0 + v1 * uv1 + v2 * uv2;
      *op = f2bf(g * frcp(1.f + __expf(-g)) * v);
      op += DFF;
      ug0 = ug1; ug1 = ug2; uv0 = uv1; uv1 = uv2;
    }
  }
  __syncthreads();
}
DEV float gelu_tanh(float x) { float u = 0.7978845608028654f * (x + 0.044715f * x * x * x); float t = 1.f - 2.f / (1.f + __expf(2.f * u)); return 0.5f * x * (1.f + t); }
DEV void gemm_c1_item(const Params& p, int l, int item, char* lds) {
  const int kv = item >> 5, mt = item & 31;
  const int tid = TIDX, lrow = grow(tid), lkc = gchunk(tid);
  const bf16_t* ab[4]; const bf16_t* bb[4];
#pragma unroll
  for (int i = 0; i < 4; ++i) {
    int r = mt * 128 + lrow + 8 * i; int b = r >> 9, g = (r >> 8) & 1, c = r & 255;
    int tk = 16 * c; if (tk > S - 32) tk = S - 32;
    ab[i] = p.P16 + (size_t)(b * S + tk) * LDP16 + (kv ? C_VC : C_KC) + g * 64 + lkc * 8;
    bb[i] = p.Wc1 + (size_t)kv * 128 * 2048 + (size_t)(lrow + 8 * i) * 2048 + lkc * 8;
  }
  const float* pb = p.pebias + (size_t)(l * 2 + kv) * 128;
  bf16_t* out = p.Hc + (size_t)kv * 4096 * 128;
  gemm128<true>(ab, LDP16, bb, 64, 32, lds, [&](f32x4 (&acc)[4][4], int wm, int wn, int fr, int fq) {
#pragma unroll
    for (int m = 0; m < 4; ++m)
#pragma unroll
      for (int n = 0; n < 4; ++n) {
        int r = mt * 128 + wm * 64 + m * 16 + fr; int col = wn * 64 + n * 16 + fq * 4;
        f32x4 bv = *(const f32x4*)(pb + col);
        f32x4 v = acc[m][n] + bv;
        u32x2 w; w.x = cvt_pk_bf16(gelu_tanh(v[0]), gelu_tanh(v[1])); w.y = cvt_pk_bf16(gelu_tanh(v[2]), gelu_tanh(v[3]));
        *(u32x2*)(out + (size_t)r * 128 + col) = w;
      }
  });
}
DEV void gemm_c2_item(const Params& p, int item, char* lds) {
  const int kv = item >> 5, mt = item & 31;
  const int tid = TIDX, lrow = grow(tid), lkc = gchunk(tid);
  const bf16_t* ab[4]; const bf16_t* bb[4];
#pragma unroll
  for (int i = 0; i < 4; ++i) {
    ab[i] = p.Hc + (size_t)kv * 4096 * 128 + (size_t)(mt * 128 + lrow + 8 * i) * 128 + lkc * 8;
    bb[i] = p.Wc2 + (size_t)kv * 128 * 128 + (size_t)(lrow + 8 * i) * 128 + lkc * 8;
  }
  if (kv == 0) {
    gemm128<true>(ab, 64, bb, 64, 2, lds, [&](f32x4 (&acc)[4][4], int wm, int wn, int fr, int fq) {
      if (wn == 0) {
#pragma unroll
        for (int m = 0; m < 4; ++m)
#pragma unroll
          for (int n = 0; n < 4; ++n) {
            int r = mt * 128 + wm * 64 + m * 16 + fr; int col = n * 16 + fq * 4;
            u32x2 w; w.x = cvt_pk_bf16(acc[m][n][0], acc[m][n][1]); w.y = cvt_pk_bf16(acc[m][n][2], acc[m][n][3]);
            *(u32x2*)(p.Kc + (size_t)r * 64 + col) = w;
          }
      }
    });
  } else {
    gemm128<false>(ab, 64, bb, 64, 2, lds, [&](f32x4 (&acc)[4][4], int wm, int wn, int fr, int fq) {
      if (wn == 0) {
#pragma unroll
        for (int m = 0; m < 4; ++m)
#pragma unroll
          for (int n = 0; n < 4; ++n) {
            int r = mt * 128 + wm * 64 + m * 16 + fq * 4; int bg = r >> 8, c = r & 255; int d = n * 16 + fr;
            u32x2 w; w.x = cvt_pk_bf16(acc[m][n][0], acc[m][n][1]); w.y = cvt_pk_bf16(acc[m][n][2], acc[m][n][3]);
            *(u32x2*)(p.VtC + ((size_t)bg * 64 + d) * 256 + c) = w;
          }
      }
    });
  }
}

DEV void rwkv_prep_item(const Params& p, int l, int item, char* lds) {
  float* sx = (float*)lds;
  const int tid = TIDX, lane = tid & 63, hd = tid >> 6;
  const int t0 = item * 64;
  const float* mu = p.mu + (size_t)l * 896;
  __syncthreads();
#pragma unroll 8
  for (int e = tid; e < 64 * 128; e += 256) {
    int tk = e >> 7, jj = e & 127; int t = t0 + tk; int col = 768 + jj;
    float pv = p.P32[(size_t)t * 128 + jj];
    float pp = (t & 4095) ? p.P32[(size_t)(t - 1) * 128 + jj] : 0.f;
    float xs = pv + (pp - pv) * mu[col];
    sx[e] = jj < 32 ? (1.f - 2.f * frcp(1.f + __expf(2.f * xs))) : (jj < 64 ? xs : fsigmoid(xs));
  }
  __syncthreads();
  const int c = tid;
  float wu[32], au[32], gu[64];
#pragma unroll
  for (int q = 0; q < 32; ++q) { wu[q] = p.w_up[((size_t)l * 32 + q) * 256 + c]; au[q] = p.a_up[((size_t)l * 32 + q) * 256 + c]; }
#pragma unroll
  for (int q = 0; q < 64; ++q) gu[q] = p.g_up[((size_t)l * 64 + q) * 256 + c];
  const float w0 = p.w0[l * 256 + c], a0 = p.a0[l * 256 + c], kkc = p.k_k[l * 256 + c], kac = p.k_a[l * 256 + c], rkc = p.r_k[l * 256 + c];
  const float mur = mu[c], muk = mu[256 + c], muv = mu[512 + c];
  float pr = 0.f, pk = 0.f, pvv = 0.f;
  if (t0 & 4095) { pr = bf2f(p.Prkv[(size_t)(t0 - 1) * 768 + c]); pk = bf2f(p.Prkv[(size_t)(t0 - 1) * 768 + 256 + c]); pvv = bf2f(p.Prkv[(size_t)(t0 - 1) * 768 + 512 + c]); }
  float gr[4], gk[4], gv[4], nr[4], nk[4], nv[4];
#pragma unroll
  for (int u = 0; u < 4; ++u) { gr[u] = bf2f(p.Prkv[(size_t)(t0 + u) * 768 + c]); gk[u] = bf2f(p.Prkv[(size_t)(t0 + u) * 768 + 256 + c]); gv[u] = bf2f(p.Prkv[(size_t)(t0 + u) * 768 + 512 + c]); }
  for (int tk4 = 0; tk4 < 64; tk4 += 4) {
    if (tk4 + 4 < 64) {
#pragma unroll
      for (int u = 0; u < 4; ++u) { const size_t o = (size_t)(t0 + tk4 + 4 + u) * 768 + c; nr[u] = bf2f(p.Prkv[o]); nk[u] = bf2f(p.Prkv[o + 256]); nv[u] = bf2f(p.Prkv[o + 512]); }
    }
#pragma unroll
    for (int u = 0; u < 4; ++u) {
      const int tk = tk4 + u;
      const int t = t0 + tk;
      float lw = 0.f, la = 0.f, lg = 0.f;
      const f32x4* xr = (const f32x4*)(sx + tk * 128);
#pragma unroll
      for (int q = 0; q < 8; ++q) { f32x4 xv = xr[q]; lw += xv[0] * wu[q * 4] + xv[1] * wu[q * 4 + 1] + xv[2] * wu[q * 4 + 2] + xv[3] * wu[q * 4 + 3]; }
#pragma unroll
      for (int q = 0; q < 8; ++q) { f32x4 xv = xr[8 + q]; la += xv[0] * au[q * 4] + xv[1] * au[q * 4 + 1] + xv[2] * au[q * 4 + 2] + xv[3] * au[q * 4 + 3]; }
#pragma unroll
      for (int q = 0; q < 16; ++q) { f32x4 xv = xr[16 + q]; lg += xv[0] * gu[q * 4] + xv[1] * gu[q * 4 + 1] + xv[2] * gu[q * 4 + 2] + xv[3] * gu[q * 4 + 3]; }
      const float cr = gr[u], ck = gk[u], cv = gv[u];
      float r = cr + (pr - cr) * mur, k = ck + (pk - ck) * muk, v = cv + (pvv - cv) * muv;
      pr = cr; pk = ck; pvv = cv;
      float wl = -fsoftplus(-(w0 + lw)) - 0.5f;
      float e = __expf(wl);
      float a = fsigmoid(a0 + la);
      float kk = k * kkc;
      float n2 = wave_sum(kk * kk);
      float kkn = kk * __builtin_amdgcn_rsqf(fmaxf(n2, 1e-24f));
      float k2 = k * (1.f + (a - 1.f) * kac);
      float bs = wave_sum(r * k2 * rkc);
      bf16_t* sc = p.SC + ((size_t)t * 4 + hd) * 320;
      sc[lane] = f2bf(r); sc[64 + lane] = f2bf(1.f - __expf(-e)); sc[128 + lane] = f2bf(k2); sc[192 + lane] = f2bf(-kkn); sc[256 + lane] = f2bf(kkn * a);
      p.SV[(size_t)t * 256 + c] = f2bf(v);
      p.SG[(size_t)t * 256 + c] = f2bf(lg);
      if (lane == 0) p.BS[(size_t)t * 4 + hd] = bs;
    }
#pragma unroll
    for (int u = 0; u < 4; ++u) { gr[u] = nr[u]; gk[u] = nk[u]; gv[u] = nv[u]; }
  }
}
DEV void fox_cum_item(const Params& p, int l, int item, char* lds) {
  float* red = (float*)lds;
  const int tid = TIDX; const int b = item / 6, h = item % 6;
  const float bf = p.b_f[l * 6 + h];
  float v[16]; float run = 0.f;
#pragma unroll
  for (int i = 0; i < 16; ++i) {
    int s = tid * 16 + i;
    float xl = p.PG[(size_t)(b * S + s) * 32 + h] + bf;
    run += -fsoftplus(-xl);
    v[i] = run;
  }
  __syncthreads();
  red[tid] = run;
  __syncthreads();
  if (tid == 0) { float a = 0.f; for (int i = 0; i < 256; ++i) { float tmp = red[i]; red[i] = a; a += tmp; } }
  __syncthreads();
  const float off = red[tid];
#pragma unroll
  for (int i = 0; i < 16; ++i) p.kbias[(size_t)item * S + tid * 16 + i] = -(v[i] + off) * LOG2E;
  __syncthreads();
}

constexpr int SCH = 16;
DEV void scan_item(const Params& p, int item, char* lds) {
  const int bh = item >> 2, rg = item & 3, b = bh >> 2, h = bh & 3;
  const int tid = TIDX, rl = tid >> 4, kq = tid & 15;
  float* buf0 = (float*)lds; constexpr int BUFSZ = SCH * 320 + SCH * 16;
  f32x2 s01 = {0.f, 0.f}, s23 = {0.f, 0.f};
  const bf16_t* scb = p.SC + ((size_t)(b * S) * 4 + h) * 320 + (size_t)rl * 1280 + kq * 4;
  const bf16_t* svb = p.SV + (size_t)(b * S) * 256 + h * 64 + rg * 16 + (size_t)rl * 256 + kq;
  float* yb = p.yscan + (size_t)(b * S) * 256 + h * 64 + rg * 16 + rl + (size_t)kq * 256;
  u32x2 gA[5], gB[5]; bf16_t gvA, gvB;
  auto gload = [&](u32x2 (&g)[5], bf16_t& gv, int ch) __attribute__((always_inline)) {
    const size_t o = (size_t)ch * SCH * 1280;
#pragma unroll
    for (int a = 0; a < 5; ++a) g[a] = *(const u32x2*)(scb + o + a * 64);
    gv = svb[(size_t)ch * SCH * 256];
  };
  auto lstore = [&](const u32x2 (&g)[5], const bf16_t& gv, float* dst) __attribute__((always_inline)) {
#pragma unroll
    for (int a = 0; a < 5; ++a) {
      f32x4 o = {__uint_as_float(g[a].x << 16), __uint_as_float(g[a].x & 0xffff0000u), __uint_as_float(g[a].y << 16), __uint_as_float(g[a].y & 0xffff0000u)};
      if (a == 1) o = 1.f - o;
      *(f32x4*)(dst + rl * 320 + a * 64 + kq * 4) = o;
    }
    dst[SCH * 320 + kq * SCH + rl] = bf2f(gv);
  };
  constexpr int NCH = S / SCH;
  auto chunk = [&](int ch, u32x2 (&g)[5], bf16_t& gv) __attribute__((always_inline)) {
    const float* cur = buf0 + (ch & 1) * BUFSZ; float* nxt = buf0 + ((ch + 1) & 1) * BUFSZ;
    if (ch + 1 < NCH) lstore(g, gv, nxt);
    if (ch + 3 < NCH) gload(g, gv, ch + 3);
    f32x4 vr[4];
#pragma unroll
    for (int q = 0; q < 4; ++q) vr[q] = *(const f32x4*)(cur + SCH * 320 + rl * SCH + q * 4);
    float ykeep = 0.f;
    f32x4 nr4, nw4, nk4, na4, nb4;
    { const float* q = cur + kq * 4; nr4 = *(const f32x4*)(q); nw4 = *(const f32x4*)(q + 64); nk4 = *(const f32x4*)(q + 128); na4 = *(const f32x4*)(q + 192); nb4 = *(const f32x4*)(q + 256); }
#pragma unroll
    for (int st = 0; st < SCH; ++st) {
      const f32x4 r4 = nr4, w4 = nw4, k4 = nk4, a4 = na4, b4 = nb4;
      if (st + 1 < SCH) { const float* q = cur + (st + 1) * 320 + kq * 4; nr4 = *(const f32x4*)(q); nw4 = *(const f32x4*)(q + 64); nk4 = *(const f32x4*)(q + 128); na4 = *(const f32x4*)(q + 192); nb4 = *(const f32x4*)(q + 256); }
      const float vv = vr[st >> 2][st & 3];
      f32x2 t = s01 * (f32x2){a4[0], a4[1]}; t = s23 * (f32x2){a4[2], a4[3]} + t;
      f32x2 u01 = s01 * (f32x2){w4[0], w4[1]} + (f32x2){k4[0], k4[1]} * vv;
      f32x2 u23 = s23 * (f32x2){w4[2], w4[3]} + (f32x2){k4[2], k4[3]} * vv;
      float sa = dpp_sum16(t[0] + t[1]);
      s01 = (f32x2){b4[0], b4[1]} * sa + u01;
      s23 = (f32x2){b4[2], b4[3]} * sa + u23;
      f32x2 yy = s01 * (f32x2){r4[0], r4[1]}; yy = s23 * (f32x2){r4[2], r4[3]} + yy;
      const float y = dpp_sum16(yy[0] + yy[1]);
      ykeep = (kq == st) ? y : ykeep;
    }
    yb[(size_t)ch * SCH * 256] = ykeep;
    __syncthreads();
  };
  __syncthreads();
  gload(gA, gvA, 0); lstore(gA, gvA, buf0);
  gload(gB, gvB, 1); gload(gA, gvA, 2);
  __syncthreads();
  for (int ch = 0; ch < NCH; ch += 2) {
    chunk(ch, gB, gvB);
    chunk(ch + 1, gA, gvA);
  }
}
DEV void rwkv_post_item(const Params& p, int l, int item) {
  const int tid = TIDX, hd = tid >> 6, c = tid;
  const float lw = p.ln_w[l * 256 + c], lb = p.ln_b[l * 256 + c];
  for (int tk = 0; tk < 64; tk += 8) {
    float y[8], v[8], g[8], bs[8];
#pragma unroll
    for (int u = 0; u < 8; ++u) {
      const int t = item * 64 + tk + u;
      y[u] = p.yscan[(size_t)t * 256 + c]; v[u] = bf2f(p.SV[(size_t)t * 256 + c]); g[u] = bf2f(p.SG[(size_t)t * 256 + c]); bs[u] = p.BS[(size_t)t * 4 + hd];
    }
#pragma unroll
    for (int u = 0; u < 8; ++u) {
      const int t = item * 64 + tk + u;
      float mean = wave_sum(y[u]) * (1.f / 64.f);
      float dlt = y[u] - mean;
      float var = wave_sum(dlt * dlt) * (1.f / 64.f);
      float yn = dlt * rsqrtf(var + 64e-5f) * lw + lb;
      p.H[(size_t)t * D + c] = f2bf((yn + bs[u] * v[u]) * g[u]);
    }
  }
}

template <int NQ> struct AttnAcc { f32x4 o[4][NQ]; float m[NQ], l[NQ]; };
template <int NQ> DEV void attn_init(AttnAcc<NQ>& st) {
#pragma unroll
  for (int nq = 0; nq < NQ; ++nq) { st.m[nq] = MINIT; st.l[nq] = 0.f;
#pragma unroll
    for (int dt = 0; dt < 4; ++dt) st.o[dt][nq] = (f32x4){0.f, 0.f, 0.f, 0.f}; }
}
struct KVSrc { const bf16_t* K; int ldk; const bf16_t* Vt; int ldv; const float* kb; };
constexpr int KV_STAGE = 2 * 64 * LS * 2;
DEV void kv_load(const KVSrc& s, int k0, u32x4 (&rk)[2], u32x4 (&rv)[2], f32x4& rkb) {
  const int tid = TIDX;
#pragma unroll
  for (int i = 0; i < 2; ++i) {
    int ch = tid + 256 * i; int row = ch >> 3, kc = ch & 7;
    rk[i] = *(const u32x4*)(s.K + (size_t)(k0 + row) * s.ldk + kc * 8);
    rv[i] = *(const u32x4*)(s.Vt + (size_t)row * s.ldv + k0 + kc * 8);
  }
  if (s.kb && tid < 16) rkb = *(const f32x4*)(s.kb + k0 + tid * 4);
}
DEV void kv_store(char* lds, int stage, const u32x4 (&rk)[2], const u32x4 (&rv)[2], const f32x4& rkb, bool haskb) {
  const int tid = TIDX;
  bf16_t* sK = (bf16_t*)(lds + stage * KV_STAGE); bf16_t* sV = sK + 64 * LS;
#pragma unroll
  for (int i = 0; i < 2; ++i) {
    int ch = tid + 256 * i; int row = ch >> 3, kc = ch & 7;
    *(u32x4*)(sK + row * LS + kc * 8) = rk[i];
    *(u32x4*)(sV + row * LS + kc * 8) = rv[i];
  }
  if (haskb && tid < 16) *(f32x4*)(lds + 2 * KV_STAGE + stage * 256 + tid * 16) = rkb;
}
template <int NQ> DEV void qk_tile(f32x4 (&s)[4][NQ], const bf16x8 (&qf)[NQ][2], const bf16_t* sK, int fr, int fq) {
#pragma unroll
  for (int kt = 0; kt < 4; ++kt) {
#pragma unroll
    for (int nq = 0; nq < NQ; ++nq) s[kt][nq] = (f32x4){0.f, 0.f, 0.f, 0.f};
#pragma unroll
    for (int ks = 0; ks < 2; ++ks) {
      bf16x8 kf = *(const bf16x8*)(sK + (kt * 16 + fr) * LS + ks * 32 + fq * 8);
#pragma unroll
      for (int nq = 0; nq < NQ; ++nq) s[kt][nq] = __builtin_amdgcn_mfma_f32_16x16x32_bf16(kf, qf[nq][ks], s[kt][nq], 0, 0, 0);
    }
  }
}
template <int NQ, bool QLDS, class BiasF>
DEV void attn_tile_q(AttnAcc<NQ>& st, const bf16x8 (&qf)[NQ][2], const char* sQw, int qsw0, int qsw1, const bf16_t* sK, const bf16_t* sV, BiasF&& bias, int fr, int fq) {
#pragma unroll
  for (int hf = 0; hf < 2; ++hf) {
    f32x4 s[2][NQ];
#pragma unroll
    for (int k2 = 0; k2 < 2; ++k2) {
#pragma unroll
      for (int nq = 0; nq < NQ; ++nq) s[k2][nq] = (f32x4){0.f, 0.f, 0.f, 0.f};
#pragma unroll
      for (int ks = 0; ks < 2; ++ks) {
        bf16x8 kf = *(const bf16x8*)(sK + ((hf * 2 + k2) * 16 + fr) * LS + ks * 32 + fq * 8);
#pragma unroll
        for (int nq = 0; nq < NQ; ++nq) { bf16x8 qv; if (QLDS) qv = *(const bf16x8*)(sQw + nq * 2048 + (ks ? qsw1 : qsw0)); else qv = qf[nq][ks];
          s[k2][nq] = __builtin_amdgcn_mfma_f32_16x16x32_bf16(kf, qv, s[k2][nq], 0, 0, 0); }
      }
    }
    bf16x8 pf[NQ];
#pragma unroll
    for (int nq = 0; nq < NQ; ++nq) {
      s[0][nq] = bias(nq, hf * 2, s[0][nq]); s[1][nq] = bias(nq, hf * 2 + 1, s[1][nq]);
      float lm = fmaxf(fmaxf(s[0][nq][0], s[0][nq][1]), s[0][nq][2]);
      lm = fmaxf(fmaxf(lm, s[0][nq][3]), s[1][nq][0]); lm = fmaxf(fmaxf(lm, s[1][nq][1]), s[1][nq][2]); lm = fmaxf(lm, s[1][nq][3]);
      float mcur = st.m[nq], lcur = st.l[nq];
      if (__builtin_amdgcn_ballot_w64(lm > mcur + 8.f) != 0ull) {
        float mx2 = fmaxf(mcur, lm);
        mx2 = fmaxf(mx2, __shfl_xor(mx2, 16)); mx2 = fmaxf(mx2, __shfl_xor(mx2, 32));
        const float alpha = fexp2(mcur - mx2); mcur = mx2;
        lcur *= alpha;
#pragma unroll
        for (int dt = 0; dt < 4; ++dt) st.o[dt][nq] = st.o[dt][nq] * alpha;
      }
      const float mx = mcur;
      const float nmx = -mx;
      f32x4 p0 = s[0][nq] + nmx, p1 = s[1][nq] + nmx;
#pragma unroll
      for (int j = 0; j < 4; ++j) { p0[j] = fexp2(p0[j]); p1[j] = fexp2(p1[j]); }
      const f32x4 sm = p0 + p1;
      st.m[nq] = mcur; st.l[nq] = lcur + ((sm[0] + sm[1]) + (sm[2] + sm[3]));
      u32x4 w; w.x = cvt_pk_bf16(p0[0], p0[1]); w.y = cvt_pk_bf16(p0[2], p0[3]); w.z = cvt_pk_bf16(p1[0], p1[1]); w.w = cvt_pk_bf16(p1[2], p1[3]);
      pf[nq] = __builtin_bit_cast(bf16x8, w);
    }
#pragma unroll
    for (int dt = 0; dt < 4; ++dt) {
      const bf16_t* vp = sV + (dt * 16 + fr) * LS + hf * 32 + fq * 4;
      u32x2 lo = *(const u32x2*)(vp), hi = *(const u32x2*)(vp + 16);
      u32x4 w; w.x = lo.x; w.y = lo.y; w.z = hi.x; w.w = hi.y;
      bf16x8 vf = __builtin_bit_cast(bf16x8, w);
#pragma unroll
      for (int nq = 0; nq < NQ; ++nq) st.o[dt][nq] = __builtin_amdgcn_mfma_f32_16x16x32_bf16(vf, pf[nq], st.o[dt][nq], 0, 0, 0);
    }
  }
}
template <int NQ, class BiasF>
DEV void attn_tile(AttnAcc<NQ>& st, const bf16x8 (&qf)[NQ][2], const bf16_t* sK, const bf16_t* sV, BiasF&& bias, int fr, int fq) {
  attn_tile_q<NQ, false>(st, qf, nullptr, 0, 0, sK, sV, bias, fr, fq);
}
template <class Body>
DEV void kv_loop(const KVSrc& src, u64 tiles, char* lds, Body&& body) {
  u32x4 rk[2], rv[2]; f32x4 rkb = {0.f, 0.f, 0.f, 0.f};
  if (tiles == 0) return;
  const bool haskb = src.kb != nullptr;
  int kt = __builtin_ctzll(tiles); tiles &= tiles - 1;
  kv_load(src, kt * 64, rk, rv, rkb);
  __syncthreads();
  kv_store(lds, 0, rk, rv, rkb, haskb);
  int nkt = -1;
  if (tiles) { nkt = __builtin_ctzll(tiles); tiles &= tiles - 1; kv_load(src, nkt * 64, rk, rv, rkb); }
  int stage = 0;
  for (;;) {
    __syncthreads();
    int nnkt = -1;
    if (nkt >= 0) {
      kv_store(lds, stage ^ 1, rk, rv, rkb, haskb);
      if (tiles) { nnkt = __builtin_ctzll(tiles); tiles &= tiles - 1; kv_load(src, nnkt * 64, rk, rv, rkb); }
    }
    const bf16_t* sK = (const bf16_t*)(lds + stage * KV_STAGE);
    body(kt, sK, sK + 64 * LS, (const float*)(lds + 2 * KV_STAGE + stage * 256));
    if (nkt < 0) break;
    kt = nkt; nkt = nnkt; stage ^= 1;
  }
}

constexpr int FNQ = 4;
constexpr int FQT = FNQ * 64;
constexpr int FOX_ITEMS = 48 * (S / FQT);
DEV void fox_item(const Params& p, int item, char* lds) {
  const int qi = (S / FQT - 1) - item / 48, bh = item % 48, b = bh / 6, h = bh % 6;
  const int q0 = qi * FQT;
  const int tid = TIDX, lane = tid & 63, wid = __builtin_amdgcn_readfirstlane(tid >> 6), fr = lane & 15, fq = lane >> 4;
  const bf16_t* Pb = p.P16 + (size_t)b * S * LDP16;
  const int qw0 = q0 + wid * (FNQ * 16);
  char* sQ = lds + 2 * KV_STAGE + 512;
  __syncthreads();
#pragma unroll
  for (int i = 0; i < FQT * 8 / 256; ++i) {
    const int ch = tid + 256 * i, row = ch >> 3, c = ch & 7;
    *(u32x4*)(sQ + row * 128 + ((c ^ (row & 7)) << 4)) = *(const u32x4*)(Pb + (size_t)(q0 + row) * LDP16 + C_FQ + h * 64 + c * 8);
  }
  const char* sQw = sQ + (wid * (FNQ * 16) + fr) * 128;
  const int qsw0 = (fq ^ (fr & 7)) << 4, qsw1 = ((4 + fq) ^ (fr & 7)) << 4;
  bf16x8 qdummy[FNQ][2];
  AttnAcc<FNQ> st; attn_init(st);
  KVSrc src{Pb + C_FK + h * 64, LDP16, p.VtF + (size_t)(b * 6 + h) * 64 * S, S, p.kbias + (size_t)(b * 6 + h) * S};
  const int nkt = (q0 + FQT) / 64;
  const u64 tiles = nkt >= 64 ? ~0ull : ((1ull << nkt) - 1);
  kv_loop(src, tiles, lds, [&](int kt, const bf16_t* sK, const bf16_t* sV, const float* sKB) __attribute__((always_inline)) {
    if (kt * 64 > qw0 + FNQ * 16 - 1) return;
    const bool diag = kt * 64 + 63 > qw0;
    attn_tile_q<FNQ, true>(st, qdummy, sQw, qsw0, qsw1, sK, sV, [&](int nq, int k16, f32x4 raw) __attribute__((always_inline)) {
      const int kl = k16 * 16 + fq * 4;
      f32x4 kb = *(const f32x4*)(sKB + kl);
      f32x4 v = raw + kb;
      if (diag) { const int qpos = qw0 + nq * 16 + fr; const int key0 = kt * 64 + kl;
#pragma unroll
        for (int j = 0; j < 4; ++j) if (key0 + j > qpos) v[j] = NEGM; }
      return v; }, fr, fq);
  });
#pragma unroll
  for (int nq = 0; nq < FNQ; ++nq) {
    float lt = st.l[nq]; lt += __shfl_xor(lt, 16); lt += __shfl_xor(lt, 32);
    const float inv = lt > 0.f ? 1.f / lt : 0.f;
    const int tok = b * S + qw0 + nq * 16 + fr;
#pragma unroll
    for (int dt = 0; dt < 4; ++dt) {
      f32x4 o = st.o[dt][nq] * inv;
      u32x2 w; w.x = cvt_pk_bf16(o[0], o[1]); w.y = cvt_pk_bf16(o[2], o[3]);
      *(u32x2*)(p.H + (size_t)tok * D + 256 + h * 64 + dt * 16 + fq * 4) = w;
    }
  }
}

DEV void nsa_cmp_item(const Params& p, int item, char* lds) {
  const int bg = item >> 6, tile = item & 63, b = bg >> 1, g = bg & 1;
  const int t0 = tile * 64;
  const int tid = TIDX, lane = tid & 63, wid = __builtin_amdgcn_readfirstlane(tid >> 6), fr = lane & 15, fq = lane >> 4;
  float* slut = (float*)(lds + 2 * KV_STAGE + 512);
  float* simp = slut + 384;
  __syncthreads();
  for (int e = tid; e < 384; e += 256) slut[e] = p.lut[(g * 3) * 128 + e];
  for (int e = tid; e < 64 * 65; e += 256) simp[e] = 0.f;
  const bf16_t* Pb = p.P16 + (size_t)b * S * LDP16;
  const int qpos = t0 + wid * 16 + fr;
  bf16x8 qf[3][2];
#pragma unroll
  for (int nq = 0; nq < 3; ++nq)
#pragma unroll
    for (int ks = 0; ks < 2; ++ks) qf[nq][ks] = *(const bf16x8*)(Pb + (size_t)qpos * LDP16 + C_NQ + (g * 3 + nq) * 64 + ks * 32 + fq * 8);
  AttnAcc<3> st; attn_init(st);
  KVSrc src{p.Kc + (size_t)bg * 256 * 64, 64, p.VtC + (size_t)bg * 64 * 256, 256, nullptr};
  const int cmaxt = (t0 + 63 - 31) >= 0 ? (t0 + 32) / 16 : -1;
  const int nkt = cmaxt >= 0 ? (cmaxt / 64 + 1) : 0;
  const u64 tiles = nkt > 0 ? ((1ull << nkt) - 1) : 0ull;
  auto biasf = [&](int kt) __attribute__((always_inline)) {
    return [&, kt](int nq, int k16, f32x4 raw) __attribute__((always_inline)) {
      const int c0 = kt * 64 + k16 * 16 + fq * 4;
      f32x4 v;
#pragma unroll
      for (int j = 0; j < 4; ++j) { int dist = qpos - (16 * (c0 + j) + 31); int dc = dist > 127 ? 127 : dist;
        v[j] = dist >= 0 ? raw[j] + slut[nq * 128 + dc] : NEGM; }
      return v; };
  };
  kv_loop(src, tiles, lds, [&](int kt, const bf16_t* sK, const bf16_t* sV, const float*) __attribute__((always_inline)) { attn_tile<3>(st, qf, sK, sV, biasf(kt), fr, fq); });
  float linv[3];
#pragma unroll
  for (int nq = 0; nq < 3; ++nq) {
    float lt = st.l[nq]; lt += __shfl_xor(lt, 16); lt += __shfl_xor(lt, 32);
    linv[nq] = lt > 0.f ? 1.f / lt : 0.f;
    const int tok = b * S + qpos; const int hh = g * 3 + nq;
    const float gate = fsigmoid(p.PG[(size_t)tok * 32 + 6 + hh * 3 + 0]);
#pragma unroll
    for (int dt = 0; dt < 4; ++dt) { const f32x4 o = st.o[dt][nq] * (linv[nq] * gate); u32x2 w; w.x = cvt_pk_bf16(o[0], o[1]); w.y = cvt_pk_bf16(o[2], o[3]);
      *(u32x2*)(p.ocmp + (size_t)tok * 384 + hh * 64 + dt * 16 + fq * 4) = w; }
  }
  const int cur = tile;
  if (cur >= 16) {
    float carry = 0.f;
    kv_loop(src, tiles, lds, [&](int kt, const bf16_t* sK, const bf16_t* sV, const float*) __attribute__((always_inline)) {
      f32x4 s[4][3];
      qk_tile<3>(s, qf, sK, fr, fq);
      auto bf = biasf(kt);
#pragma unroll
      for (int k16 = 0; k16 < 4; ++k16) {
        f32x4 ph = (f32x4){0.f, 0.f, 0.f, 0.f};
#pragma unroll
        for (int nq = 0; nq < 3; ++nq) { f32x4 v = bf(nq, k16, s[k16][nq]);
#pragma unroll
          for (int j = 0; j < 4; ++j) ph[j] += v[j] < -1e29f ? 0.f : fexp2(v[j] - st.m[nq]) * linv[nq]; }
        const float s4 = (ph[0] + ph[1]) + (ph[2] + ph[3]);
        const float up = __shfl(ph[3], (lane + 48) & 63);
        const float upc = __shfl(carry, (lane + 48) & 63);
        const float prevp = fq == 0 ? upc : up;
        carry = ph[3];
        const int jb = kt * 16 + k16 * 4 + fq;
        simp[(wid * 16 + fr) * 65 + jb] = s4 + prevp;
      }
    });
  }
  __syncthreads();
  for (int tl = 0; tl < 16; ++tl) {
    const int tk = wid * 16 + tl;
    const int jb = lane;
    const bool valid = jb <= cur;
    const bool forced = (jb == 0) || (valid && (cur - jb) < 2);
    const float score = valid ? (forced ? 1e4f : simp[tk * 65 + jb]) : -1.f;
    int rank = 0;
#pragma unroll
    for (int j2 = 0; j2 < 64; ++j2) {
      const float s2 = __int_as_float(__builtin_amdgcn_readlane(__float_as_int(score), j2));
      rank += (s2 > score || (s2 == score && j2 < jb)) ? 1 : 0;
    }
    const bool sel = rank < 16 && score >= 0.f;
    const u64 m = __ballot(sel);
    if (lane == 0) p.selmask[(size_t)bg * S + t0 + tk] = m;
  }
  __syncthreads();
}

DEV void nsa_sw_item(const Params& p, int item, char* lds) {
  const int bg = item >> 6, tile = 63 - (item & 63), b = bg >> 1, g = bg & 1;
  const int t0 = tile * 64, cur = tile;
  const int tid = TIDX, lane = tid & 63, wid = __builtin_amdgcn_readfirstlane(tid >> 6), fr = lane & 15, fq = lane >> 4;
  float* slut = (float*)(lds + 2 * KV_STAGE + 512);
  u64* sor = (u64*)(slut + 384);
  __syncthreads();
  for (int e = tid; e < 384; e += 256) slut[e] = p.lut[(g * 3) * 128 + e];
  const bf16_t* Pb = p.P16 + (size_t)b * S * LDP16;
  const int qpos = t0 + wid * 16 + fr;
  const u64 mymask = p.selmask[(size_t)bg * S + qpos];
  { u64 m = mymask;
#pragma unroll
    for (int o = 1; o < 16; o <<= 1) { unsigned lo = __shfl_xor((unsigned)m, o), hi = __shfl_xor((unsigned)(m >> 32), o); m |= ((u64)hi << 32) | lo; }
    if (lane == 0) sor[wid] = m; }
  __syncthreads();
  const u64 umv = sor[0] | sor[1] | sor[2] | sor[3];
  const u64 um = ((u64)(unsigned)__builtin_amdgcn_readfirstlane((int)(umv >> 32)) << 32) | (u64)(unsigned)__builtin_amdgcn_readfirstlane((int)(unsigned)umv);
  bf16x8 qf[3][2];
#pragma unroll
  for (int nq = 0; nq < 3; ++nq)
#pragma unroll
    for (int ks = 0; ks < 2; ++ks) qf[nq][ks] = *(const bf16x8*)(Pb + (size_t)qpos * LDP16 + C_NQ + (g * 3 + nq) * 64 + ks * 32 + fq * 8);
  const float c31[3] = {slut[127], slut[128 + 127], slut[256 + 127]};
  {
    AttnAcc<3> st; attn_init(st);
    KVSrc src{Pb + C_KS + g * 64, LDP16, p.VtS + (size_t)bg * 64 * S, S, nullptr};
    kv_loop(src, um, lds, [&](int kt, const bf16_t* sK, const bf16_t* sV, const float*) __attribute__((always_inline)) {
      const bool mine = (mymask >> kt) & 1ull;
      const bool nearb = (cur - kt) <= 2;
      attn_tile<3>(st, qf, sK, sV, [&](int nq, int k16, f32x4 raw) __attribute__((always_inline)) {
        f32x4 v;
        if (!mine) { v = (f32x4){NEGM, NEGM, NEGM, NEGM}; }
        else if (!nearb) { v = raw + c31[nq]; }
        else {
          const int key0 = kt * 64 + k16 * 16 + fq * 4;
#pragma unroll
          for (int j = 0; j < 4; ++j) { int dist = qpos - (key0 + j); int dc = dist > 127 ? 127 : dist;
            v[j] = dist >= 0 ? raw[j] + slut[nq * 128 + dc] : NEGM; }
        }
        return v; }, fr, fq);
    });
#pragma unroll
    for (int nq = 0; nq < 3; ++nq) {
      float lt = st.l[nq]; lt += __shfl_xor(lt, 16); lt += __shfl_xor(lt, 32);
      const float inv = lt > 0.f ? 1.f / lt : 0.f;
      const int tok = b * S + qpos; const int hh = g * 3 + nq;
      const float gate = fsigmoid(p.PG[(size_t)tok * 32 + 6 + hh * 3 + 1]);
#pragma unroll
      for (int dt = 0; dt < 4; ++dt) {
        { const f32x4 o = st.o[dt][nq] * (inv * gate); u32x2 w; w.x = cvt_pk_bf16(o[0], o[1]); w.y = cvt_pk_bf16(o[2], o[3]);
          *(u32x2*)(p.oslc + (size_t)tok * 384 + hh * 64 + dt * 16 + fq * 4) = w; }
      }
    }
  }
  {
    AttnAcc<3> st; attn_init(st);
    KVSrc src{Pb + C_KW + g * 64, LDP16, p.VtW + (size_t)bg * 64 * S, S, nullptr};
    const int klo = cur - 8 < 0 ? 0 : cur - 8;
    u64 tiles = 0; for (int k = klo; k <= cur; ++k) tiles |= 1ull << k;
    kv_loop(src, tiles, lds, [&](int kt, const bf16_t* sK, const bf16_t* sV, const float*) __attribute__((always_inline)) {
      const bool nearb = (cur - kt) <= 2;
      const bool far = (cur - kt) == 8;
      attn_tile<3>(st, qf, sK, sV, [&](int nq, int k16, f32x4 raw) __attribute__((always_inline)) {
        f32x4 v;
        const int key0 = kt * 64 + k16 * 16 + fq * 4;
        if (nearb) {
#pragma unroll
          for (int j = 0; j < 4; ++j) { int dist = qpos - (key0 + j); int dc = dist > 127 ? 127 : dist;
            v[j] = dist >= 0 ? raw[j] + slut[nq * 128 + dc] : NEGM; }
        } else {
          v = raw + c31[nq];
          if (far) {
#pragma unroll
            for (int j = 0; j < 4; ++j) if (qpos - (key0 + j) >= 512) v[j] = NEGM;
          }
        }
        return v; }, fr, fq);
    });
#pragma unroll
    for (int nq = 0; nq < 3; ++nq) {
      float lt = st.l[nq]; lt += __shfl_xor(lt, 16); lt += __shfl_xor(lt, 32);
      const float inv = lt > 0.f ? 1.f / lt : 0.f;
      const int tok = b * S + qpos; const int hh = g * 3 + nq;
      const float gate = fsigmoid(p.PG[(size_t)tok * 32 + 6 + hh * 3 + 2]);
#pragma unroll
      for (int dt = 0; dt < 4; ++dt) {
        const u32x2 wc = *(const u32x2*)(p.ocmp + (size_t)tok * 384 + hh * 64 + dt * 16 + fq * 4), ws = *(const u32x2*)(p.oslc + (size_t)tok * 384 + hh * 64 + dt * 16 + fq * 4);
        f32x4 oc = (f32x4){__uint_as_float(wc.x << 16), __uint_as_float(wc.x & 0xffff0000u), __uint_as_float(wc.y << 16), __uint_as_float(wc.y & 0xffff0000u)}
                 + (f32x4){__uint_as_float(ws.x << 16), __uint_as_float(ws.x & 0xffff0000u), __uint_as_float(ws.y << 16), __uint_as_float(ws.y & 0xffff0000u)};
        f32x4 o = st.o[dt][nq] * (inv * gate) + oc;
        u32x2 w; w.x = cvt_pk_bf16(o[0], o[1]); w.y = cvt_pk_bf16(o[2], o[3]);
        *(u32x2*)(p.H + (size_t)tok * D + 640 + hh * 64 + dt * 16 + fq * 4) = w;
      }
    }
  }
  __syncthreads();
}


#define XB_TMO      128
#define XB_XCNT(j)  (256  + 64 * (j))
#define XB_XSUB(j)  (1280 + 64 * (j))
#define XB_XGEN(j)  (2304 + 64 * (j))
#define XB_TOP      3328
#define XB_TOPGEN   3392
#define XCD_BAR_WORDS 3456
#define XB_SPIN_CAP (1u << 22)
#define LAS __attribute__((address_space(3)))
DEV unsigned xb_ld(unsigned* p) { return __hip_atomic_load(p, __ATOMIC_RELAXED, __HIP_MEMORY_SCOPE_AGENT); }
DEV unsigned xb_add(unsigned* p, unsigned v) { return __hip_atomic_fetch_add(p, v, __ATOMIC_RELAXED, __HIP_MEMORY_SCOPE_AGENT); }
DEV unsigned xb_xcc_id() { return (unsigned)__builtin_amdgcn_s_getreg((3 << 11) | 20) & 0xFu; }
#define XB_SPIN(cond, bar) do { unsigned _sp = 0; while (cond) { __builtin_amdgcn_s_sleep(1); \
    if ((++_sp & 255u) == 0u) { if (xb_ld(&(bar)[XB_TMO])) break; if (_sp > XB_SPIN_CAP) { atomicAdd(&(bar)[XB_TMO], 1u); break; } } } } while (0)
struct XcdBarrier { unsigned* bar; unsigned x; volatile LAS unsigned* st; };
DEV XcdBarrier xcd_barrier_post(unsigned* bar, volatile LAS unsigned* st) {
  XcdBarrier b; b.bar = bar; b.x = xb_xcc_id(); b.st = st;
  if (threadIdx.x == 0) (void)xb_add(&bar[XB_XCNT(b.x)], 1u);
  return b;
}
DEV void xcd_barrier_complete(unsigned* bar, unsigned x, unsigned& nloc, unsigned& nx) {
  const unsigned G = gridDim.x;
  unsigned sum, cnt, mine, sp = 0u;
  for (;;) {
    sum = 0u; cnt = 0u; mine = 0u;
#pragma unroll
    for (unsigned j = 0; j < 16; ++j) { const unsigned c = xb_ld(&bar[XB_XCNT(j)]); sum += c; cnt += (c > 0u) ? 1u : 0u; mine = (j == x) ? c : mine; }
    if (sum == G) break;
    __builtin_amdgcn_s_sleep(1);
    if ((++sp & 255u) == 0u) { if (xb_ld(&bar[XB_TMO])) break; if (sp > XB_SPIN_CAP) { atomicAdd(&bar[XB_TMO], 1u); break; } }
  }
  nloc = mine > 0u ? mine : 1u; nx = cnt > 0u ? cnt : 1u;
}
DEV void xcd_barrier(const XcdBarrier& b) {
  asm volatile("s_waitcnt vmcnt(0)" ::: "memory");
  __syncthreads();
  if (threadIdx.x == 0) {
    unsigned* bar = b.bar;
    __builtin_amdgcn_s_waitcnt(0);
    unsigned nloc = b.st[0], nx = b.st[1];
    if (nloc == 0u) { xcd_barrier_complete(bar, b.x, nloc, nx); b.st[0] = nloc; b.st[1] = nx; }
    const unsigned old = xb_add(&bar[XB_XSUB(b.x)], 1u);
    const unsigned gen = old / nloc;
    if (old + 1u == (gen + 1u) * nloc) {
      __builtin_amdgcn_fence(__ATOMIC_RELEASE, "agent");
      asm volatile("s_waitcnt vmcnt(0)" ::: "memory");
      const unsigned og = xb_add(&bar[XB_TOP], 1u);
      const unsigned tg = og / nx;
      if (og + 1u == (tg + 1u) * nx) xb_add(&bar[XB_TOPGEN], 1u);
      else XB_SPIN(xb_ld(&bar[XB_TOPGEN]) == tg, bar);
      __builtin_amdgcn_fence(__ATOMIC_ACQUIRE, "agent");
      xb_add(&bar[XB_XGEN(b.x)], 1u);
      asm volatile("s_waitcnt vmcnt(0)" ::: "memory");
    } else {
      XB_SPIN(xb_ld(&bar[XB_XGEN(b.x)]) == gen, bar);
      __builtin_amdgcn_fence(__ATOMIC_ACQUIRE, "agent");
      asm volatile("s_waitcnt vmcnt(0)" ::: "memory");
    }
  }
  __syncthreads();
}

DEV int next_item(unsigned* ctr, volatile int* sh) {
  __syncthreads();
  if (TIDX == 0) *sh = (int)__hip_atomic_fetch_add(ctr, 1u, __ATOMIC_RELAXED, __HIP_MEMORY_SCOPE_AGENT);
  __syncthreads();
  return __builtin_amdgcn_readfirstlane(*sh);
}
DEV bool xcd_tile(int q, int Mper, int Nt, int& m, int& n) {
  if (q >= Mper * Nt) return false;
  const int g = q / (8 * Nt), rem = q - g * 8 * Nt;
  const int gsz = (Mper - 8 * g) < 8 ? (Mper - 8 * g) : 8;
  n = rem / gsz; m = (blockIdx.x & 7) * Mper + 8 * g + rem % gsz;
  return true;
}
constexpr int NPHASE = 2 + 10 * 4;
DEV void run_phase(const Params& p, int ph, char* lds, volatile int* shq, int probe = 0) {
  const int G = gridDim.x, bid = blockIdx.x;
  if (ph == 0) {
    const int m1 = 384, m2 = m1 + 128, m3 = m2 + 1;
    const int n1 = m3 + CV_IN, n2 = n1 + CV_OUT, n3 = n2 + CV_UP, n4 = n3 + CV_DOWN, n5 = n4 + CV_C1, n6 = n5 + CV_C2;
    for (int it = bid; it < n6; it += G) {
      if (it < m1) mod_item(p, it, lds);
      else if (it < m2) pebias_item(p, it - m1, lds);
      else if (it < m3) lut_item(p);
      else if (it < n1) cvt_in_item(p, 0, it - m3, lds);
      else if (it < n2) cvt_out_item(p, 0, it - n1, lds);
      else if (it < n3) cvt_up_item(p, 0, it - n2, lds);
      else if (it < n4) cvt_down_item(p, 0, it - n3, lds);
      else if (it < n5) cvt_c1_item(p, 0, it - n4, lds);
      else cvt_c2_item(p, 0, it - n5, lds);
    }
    return;
  }
  if (ph == 1) {
    if (bid == 0) pebias_final(p);
    norm_rows(nullptr, nullptr, nullptr, p.x, nullptr, p.norm_g + 0, p.mod + 1 * 1024, p.mod + 0 * 1024, p.H);
    return;
  }
  const int l = (ph - 2) / 10, sp = (ph - 2) % 10;
  const float* modl = p.mod + (size_t)l * 8 * 6144;
  const float* ng = p.norm_g + (size_t)l * 4 * 1024;
  switch (sp) {
    case 0: { int m, n; for (int q = bid >> 3; xcd_tile(q, 32, 26, m, n); q += G >> 3) gemm_in_item(p, m * 26 + n, lds); } break;
    case 1: {
      const int n1 = 64, n2 = n1 + 512, n3 = n2 + 48, n4 = n3 + (l < 3 ? CV_IN / 4 : 0);
      for (;;) {
        const int it = next_item(p.bar + ph + probe * 64, shq);
        if (it >= n4) break;
        if (it < n1) { gemm_c1_item(p, l, it, lds); __syncthreads(); gemm_c2_item(p, it, lds); }
        else if (it < n2) rwkv_prep_item(p, l, it - n1, lds);
        else if (it < n3) fox_cum_item(p, l, it - n2, lds);
        else { for (int k = 0; k < 4; ++k) cvt_in_item(p, l + 1, (it - n3) * 4 + k, lds); }
      }
    } break;
    case 2: break;
    case 3: {
      const int n1 = 128, n2 = n1 + FOX_ITEMS, n3 = n2 + 1024, n3b = n3 + (l < 3 ? (CV_C1 + CV_C2) / 4 : 0);
      const int n4 = n3b + (l > 0 ? (CV_OUT + CV_UP + CV_DOWN) / 4 : 0);
      if (bid < n1) scan_item(p, bid, lds);
      for (;;) {
        const int it = n1 + next_item(p.bar + ph + probe * 64, shq);
        if (it >= n4) break;
        if (it < n2) fox_item(p, it - n1, lds);
        else if (it < n3) nsa_cmp_item(p, it - n2, lds);
        else if (it < n3b) {
          for (int k = 0; k < 4; ++k) { const int q = (it - n3) * 4 + k; if (q < CV_C1) cvt_c1_item(p, l + 1, q, lds); else cvt_c2_item(p, l + 1, q - CV_C1, lds); }
        } else {
          for (int k = 0; k < 4; ++k) { const int q = (it - n3b) * 4 + k;
            if (q < CV_OUT) cvt_out_item(p, l, q, lds); else if (q < CV_OUT + CV_UP) cvt_up_item(p, l, q - CV_OUT, lds); else cvt_down_item(p, l, q - CV_OUT - CV_UP, lds); }
        }
      }
    } break;
    case 4: {
      const int n1 = 1024, n2 = n1 + 512;
      for (;;) {
        const int it = next_item(p.bar + ph + probe * 64, shq);
        if (it >= n2) break;
        if (it < n1) nsa_sw_item(p, ((it & 15) << 6) | (it >> 4), lds);
        else rwkv_post_item(p, l, it - n1);
      }
    } break;
    case 5: { int m, n; for (int q = bid >> 3; xcd_tile(q, 32, 8, m, n); q += G >> 3) gemm_f32_item(p, p.H, D, p.Wt_out, (bf16_t*)p.ybuf, m * 8 + n, lds); } break;
    case 6: {
      norm_rows((const bf16_t*)p.ybuf, ng + 1024, modl + 2 * 1024, l == 0 ? p.x : p.xo, p.xo, ng + 2 * 1024, modl + 4 * 1024, modl + 3 * 1024, p.H);
    } break;
    case 7: { int m, n; for (int q = bid >> 3; xcd_tile(q, 33, 44, m, n); q += G >> 3) gemm_up_item(p, l, m * 44 + n, lds); } break;
    case 8: { int m, n; for (int q = bid >> 3; xcd_tile(q, 32, 8, m, n); q += G >> 3) gemm_f32_item(p, p.act, DFF, p.Wt_down, (bf16_t*)p.ybuf, m * 8 + n, lds); } break;
    case 9: {
      if (l < 3) {
        const float* modn = p.mod + (size_t)(l + 1) * 8 * 6144;
        norm_rows((const bf16_t*)p.ybuf, ng + 3 * 1024, modl + 5 * 1024, p.xo, p.xo, p.norm_g + (size_t)(l + 1) * 4 * 1024, modn + 1 * 1024, modn + 0 * 1024, p.H);
      } else {
        norm_rows((const bf16_t*)p.ybuf, ng + 3 * 1024, modl + 5 * 1024, p.xo, p.xo, nullptr, nullptr, nullptr, nullptr);
      }
    } break;
  }
}

__global__ void __launch_bounds__(256, 2) fwd_kernel(Params p) {
  __shared__ __attribute__((aligned(16))) char lds[LDSB];
  __shared__ uint4 xb_words;
  __shared__ int shq;
  if (threadIdx.x == 0) xb_words = make_uint4(0u, 0u, 0u, 0u);
  __syncthreads();
  XcdBarrier xb = xcd_barrier_post(p.bar, (volatile LAS unsigned*)&xb_words);
  for (int ph = p.ph0; ph < p.ph1; ++ph) {
    if (ph >= 2 && (ph - 2) % 10 == 2) continue;
    run_phase(p, ph, lds, &shq);
#ifdef DUP_SP
    if (ph >= 2 && (ph - 2) % 10 == DUP_SP) { xcd_barrier(xb); run_phase(p, ph, lds, &shq, 1); }
#endif
    if (ph + 1 < p.ph1) { if (p.ph1 > NPHASE) cg::this_grid().sync(); else xcd_barrier(xb); }
  }
}

#ifdef DBG_NPH
__global__ void dbg_dump(Params p, int which) {
  size_t i = (size_t)blockIdx.x * 256 + threadIdx.x;
  float v;
  if (which == 0) v = bf2f(p.H[i]);
  else if (which == 1) v = bf2f(p.P16[i]);
  else if (which == 2) v = p.P32[i];
  else if (which == 3) v = bf2f(p.SC[i]);
  else if (which == 4) v = bf2f(p.VtF[i % ((size_t)48 * 64 * S)]);
  else if (which == 6) v = bf2f(p.Wt_in[i % ((size_t)NINP * D)]);
  else if (which == 7) v = p.mod[i % ((size_t)4 * 8 * 6144)];
  else v = (float)(p.selmask[i % ((size_t)16 * S)] % 1000003ull);
  p.xo[i] = v;
}
#endif
extern "C" void kernel_launch(void* const* d_in, const int* in_sizes, int n_in, void* d_out, int out_size, void* d_ws, size_t ws_size, hipStream_t stream) {
  Params p{};
  const float** ins = (const float**)&p.x;
  for (int i = 0; i < 30; ++i) ins[i] = (const float*)d_in[i];
  p.xo = (float*)d_out;
  char* w = (char*)d_ws; size_t off = 0;
  auto take = [&](size_t bytes) __attribute__((always_inline)) { char* r = w + off; off += (bytes + 255) & ~(size_t)255; return r; };
  p.bar = (unsigned*)take(65536);
  p.Wt_in = (bf16_t*)take((size_t)NINP * D * 2);
  p.Wt_out = (bf16_t*)take((size_t)D * D * 2);
  p.Wt_up = (bf16_t*)take((size_t)2 * DFF * D * 2);
  p.Wt_down = (bf16_t*)take((size_t)D * DFF * 2);
  p.Wc1 = (bf16_t*)take((size_t)2 * 128 * 2048 * 2);
  p.Wc2 = (bf16_t*)take((size_t)2 * 128 * 128 * 2);
  p.mod = (float*)take((size_t)4 * 8 * 6144 * 4);
  p.pebias = (float*)take(8 * 128 * 4);
  p.pepart = (float*)take(128 * 128 * 4);
  p.lut = (float*)take(6 * 128 * 4);
  p.kbias = (float*)take((size_t)48 * S * 4);
  p.BS = (float*)take((size_t)T * 4 * 4);
  p.selmask = (u64*)take((size_t)16 * S * 8);
  p.Hc = (bf16_t*)take((size_t)2 * 4096 * 128 * 2);
  p.Kc = (bf16_t*)take((size_t)16 * 256 * 64 * 2);
  p.VtC = (bf16_t*)take((size_t)16 * 64 * 256 * 2);
  p.H = (bf16_t*)take((size_t)T * D * 2);
  char* ra = take((size_t)T * D * 4);
  p.Prkv = (bf16_t*)(ra + (size_t)T * 128 * 4);
  p.P32 = (float*)ra; p.ybuf = (float*)ra; p.yscan = (float*)ra; p.ocmp = (bf16_t*)(ra + (size_t)T * 256 * 4); p.oslc = (bf16_t*)(ra + (size_t)T * 640 * 4);
  char* rb = w + off;
  p.act = (bf16_t*)rb;
  p.P16 = (bf16_t*)take((size_t)T * LDP16 * 2);
  p.VtF = (bf16_t*)take((size_t)48 * 64 * S * 2);
  p.VtS = (bf16_t*)take((size_t)16 * 64 * S * 2);
  p.VtW = (bf16_t*)take((size_t)16 * 64 * S * 2);
  p.PG = (float*)take((size_t)T * 32 * 4);
  p.SC = (bf16_t*)take((size_t)T * 4 * 320 * 2);
  p.SV = (bf16_t*)take((size_t)T * 256 * 2);
  p.SG = (bf16_t*)take((size_t)T * 256 * 2);
  if (off > ws_size) fprintf(stderr, "workspace too small: need %zu have %zu\n", off, ws_size);
  static int grid_blocks = 0;
  if (!grid_blocks) {
    int dev = 0, cus = 0, per_cu = 0;
    hipGetDevice(&dev);
    hipDeviceGetAttribute(&cus, hipDeviceAttributeMultiprocessorCount, dev);
    hipOccupancyMaxActiveBlocksPerMultiprocessor(&per_cu, fwd_kernel, 256, 0);
    if (per_cu > 2) per_cu = 2;
    if (per_cu < 1) per_cu = 1;
    grid_blocks = cus * per_cu;
  }
#if SINGLE_LAUNCH
  p.ph0 = 0; p.ph1 = NPHASE;
  hipMemsetAsync(p.bar, 0, XCD_BAR_WORDS * 4, stream);
  void* args[] = {&p};
  hipError_t e = hipLaunchCooperativeKernel((void*)fwd_kernel, dim3(grid_blocks), dim3(256), args, 0, stream);
  if (e != hipSuccess) fprintf(stderr, "cooperative launch failed: %s (grid %d)\n", hipGetErrorString(e), grid_blocks);
#else
#ifdef DBG_NPH
  for (int ph = 0; ph < DBG_NPH; ++ph) {
    p.ph0 = ph; p.ph1 = ph + 1;
    hipLaunchKernelGGL(fwd_kernel, dim3(grid_blocks), dim3(256), 0, stream, p);
  }
  hipLaunchKernelGGL(dbg_dump, dim3(T * D / 256), dim3(256), 0, stream, p, DBG_BUF);
#else
  for (int ph = 0; ph < NPHASE; ++ph) {
    p.ph0 = ph; p.ph1 = ph + 1;
    hipLaunchKernelGGL(fwd_kernel, dim3(grid_blocks), dim3(256), 0, stream, p);
  }
#endif
#endif
}
```
